# Optimizing an MI355X kernel written in HIP

```python
import math
import jax, jax.numpy as jnp
from jax import lax
import numpy as np

D_MODEL = 1024
BATCH = 16
SEQ = 2048
DEPTH = 1
DEC_BATCH = 8
DEC_SEQ = 2048
PAST_LEN = 128

N_HEADS = 8
HEAD_DIM = 64
V_HEAD_DIM = 2 * HEAD_DIM
QK_WIDTH = 2 * N_HEADS * HEAD_DIM
V_WIDTH = N_HEADS * V_HEAD_DIM
N_FOURIER_GROUPS = 4
FOURIER_GROUP = 128
FOURIER_WIDTH = N_FOURIER_GROUPS * FOURIER_GROUP
IN_WIDTH = 2 * QK_WIDTH + V_WIDTH + FOURIER_WIDTH
N_BRANCHES = 2
D_FF = 4 * D_MODEL
ROPE_THETA = 10000.0
Q_BLOCK = 128
EPS = 1e-6
LAMBDA_STD = 0.1

kernel_name = "gated_diffattn_fnet_encoder"


def rmsnorm(x, g):
    xf = x.astype(jnp.float32)
    y = xf * lax.rsqrt(jnp.mean(xf * xf, axis=-1, keepdims=True) + EPS)
    return (y * g.astype(jnp.float32)).astype(x.dtype)


def rope(x):
    S, Dh = x.shape[2], x.shape[3]
    half = Dh // 2
    freqs = ROPE_THETA ** (-jnp.arange(half, dtype=jnp.float32) * 2.0 / Dh)
    ang = jnp.arange(S, dtype=jnp.float32)[:, None] * freqs[None, :]
    cos, sin = jnp.cos(ang), jnp.sin(ang)
    xf = x.astype(jnp.float32)
    x1, x2 = xf[..., :half], xf[..., half:]
    out = jnp.concatenate([x1 * cos - x2 * sin, x2 * cos + x1 * sin], axis=-1)
    return out.astype(x.dtype)


def diff_attention(q, k, v, lam):
    B, H2, S, Dh = q.shape
    nb = S // Q_BLOCK
    qb = q.reshape(B, H2, nb, Q_BLOCK, Dh).transpose(2, 0, 1, 3, 4)
    scale = Dh ** -0.5

    def block(qblk):
        s = jnp.einsum('bhqd,bhkd->bhqk', qblk, k, preferred_element_type=jnp.float32) * scale
        p = jax.nn.softmax(s, axis=-1).reshape(B, N_HEADS, 2, Q_BLOCK, S)
        a = p[:, :, 0] - lam * p[:, :, 1]
        return jnp.einsum('bhqk,bhkd->bhqd', a.astype(v.dtype), v)

    o = lax.map(block, qb)
    return o.transpose(1, 2, 0, 3, 4).reshape(B, N_HEADS, S, V_HEAD_DIM)


def encoder_layer(x, lambda_init, g_mix, w_in, g_q, g_k, lam_q1, lam_k1, lam_q2, lam_k2,
                  g_sub, w_attn_br, w_four_br, w_gate, b_gate, w_out, g_mlp, w_up, w_down):
    B, S, _ = x.shape
    h = rmsnorm(x, g_mix)
    proj = h @ w_in
    q, k, v, f = jnp.split(proj, [QK_WIDTH, 2 * QK_WIDTH, 2 * QK_WIDTH + V_WIDTH], axis=-1)

    q = rmsnorm(q.reshape(B, S, 2 * N_HEADS, HEAD_DIM), g_q).transpose(0, 2, 1, 3)
    k = rmsnorm(k.reshape(B, S, 2 * N_HEADS, HEAD_DIM), g_k).transpose(0, 2, 1, 3)
    q, k = rope(q), rope(k)
    v = v.reshape(B, S, N_HEADS, V_HEAD_DIM).transpose(0, 2, 1, 3)
    lam = (jnp.exp(jnp.sum(lam_q1.astype(jnp.float32) * lam_k1.astype(jnp.float32)))
           - jnp.exp(jnp.sum(lam_q2.astype(jnp.float32) * lam_k2.astype(jnp.float32)))
           + lambda_init)
    o = diff_attention(q, k, v, lam)
    o = rmsnorm(o, g_sub) * (1.0 - lambda_init)
    o = o.transpose(0, 2, 1, 3).reshape(B, S, V_WIDTH)
    attn_out = o @ w_attn_br

    fg = f.reshape(B, S, N_FOURIER_GROUPS, FOURIER_GROUP).astype(jnp.float32)
    fr = jnp.real(jnp.fft.fft2(fg, axes=(1, 3), norm='ortho')).astype(x.dtype)
    four_out = fr.reshape(B, S, FOURIER_WIDTH) @ w_four_br

    gates = jax.nn.sigmoid((h @ w_gate + b_gate).astype(jnp.float32)).astype(x.dtype)
    gates = gates.reshape(B, S, N_BRANCHES, D_MODEL)
    mixed = gates[:, :, 0] * attn_out + gates[:, :, 1] * four_out
    x = x + mixed @ w_out

    h2 = rmsnorm(x, g_mlp)
    u = jnp.square(jax.nn.relu(h2 @ w_up))
    return x + u @ w_down


def setup_inputs(seed: int = 0) -> dict:
    key = jax.random.key(seed)
    ks = jax.random.split(key, 20)
    f32 = jnp.float32

    def nrm(k, shape, scale):
        return jax.random.normal(k, shape, f32) * scale

    def gain(k, shape):
        return 1.0 + 0.02 * jax.random.normal(k, shape, f32)

    L = DEPTH
    return {
        "x_prompt": jax.random.normal(ks[0], (BATCH, SEQ, D_MODEL), f32),
        "x_sample": jax.random.normal(ks[1], (DEC_BATCH, DEC_SEQ, D_MODEL), f32),
        "g_mix": gain(ks[2], (L, D_MODEL)),
        "w_in": nrm(ks[3], (L, D_MODEL, IN_WIDTH), D_MODEL ** -0.5),
        "g_q": gain(ks[4], (L, HEAD_DIM)),
        "g_k": gain(ks[5], (L, HEAD_DIM)),
        "lam_q1": nrm(ks[6], (L, HEAD_DIM), LAMBDA_STD),
        "lam_k1": nrm(ks[7], (L, HEAD_DIM), LAMBDA_STD),
        "lam_q2": nrm(ks[8], (L, HEAD_DIM), LAMBDA_STD),
        "lam_k2": nrm(ks[9], (L, HEAD_DIM), LAMBDA_STD),
        "g_sub": gain(ks[10], (L, V_HEAD_DIM)),
        "w_attn_br": nrm(ks[11], (L, V_WIDTH, D_MODEL), V_WIDTH ** -0.5),
        "w_four_br": nrm(ks[12], (L, FOURIER_WIDTH, D_MODEL), FOURIER_WIDTH ** -0.5),
        "w_gate": nrm(ks[13], (L, D_MODEL, N_BRANCHES * D_MODEL), D_MODEL ** -0.5),
        "b_gate": nrm(ks[14], (L, N_BRANCHES * D_MODEL), 0.02),
        "w_out": nrm(ks[15], (L, D_MODEL, D_MODEL), D_MODEL ** -0.5),
        "g_mlp": gain(ks[16], (L, D_MODEL)),
        "w_up": nrm(ks[17], (L, D_MODEL, D_FF), D_MODEL ** -0.5),
        "w_down": nrm(ks[18], (L, D_FF, D_MODEL), D_FF ** -0.5),
    }


def reference(x_prompt, x_sample, g_mix, w_in, g_q, g_k, lam_q1, lam_k1, lam_q2, lam_k2,
              g_sub, w_attn_br, w_four_br, w_gate, b_gate, w_out, g_mlp, w_up, w_down):
    yp, ys = x_prompt, x_sample
    for l in range(DEPTH):
        lambda_init = 0.8 - 0.6 * math.exp(-0.3 * l)
        params = (g_mix[l], w_in[l], g_q[l], g_k[l], lam_q1[l], lam_k1[l], lam_q2[l], lam_k2[l],
                  g_sub[l], w_attn_br[l], w_four_br[l], w_gate[l], b_gate[l], w_out[l],
                  g_mlp[l], w_up[l], w_down[l])
        yp = encoder_layer(yp, lambda_init, *params)
        ys = encoder_layer(ys, lambda_init, *params)
    return (yp, ys)
```

```cpp
#include <hip/hip_runtime.h>
#include <hip/hip_cooperative_groups.h>
#include <hip/hip_bf16.h>
#include <cstdio>
#include <cstdint>
namespace cg = cooperative_groups;

#ifndef MK_N_LAUNCHES
#define MK_N_LAUNCHES 1
#endif

#ifndef REP_P0
#define REP_P0 1
#endif
#ifndef REP_P1A
#define REP_P1A 1
#endif
#ifndef REP_P1B
#define REP_P1B 1
#endif
#ifndef REP_DFT
#define REP_DFT 1
#endif
#ifndef REP_P3
#define REP_P3 1
#endif
#ifndef REP_P5
#define REP_P5 1
#endif
#define LAS __attribute__((address_space(3)))
#define GAS __attribute__((address_space(1)))
typedef unsigned short bf16_t;
typedef short bf16x8 __attribute__((ext_vector_type(8)));
typedef float f32x4 __attribute__((ext_vector_type(4)));
typedef float f32x2 __attribute__((ext_vector_type(2)));
typedef float f32x16 __attribute__((ext_vector_type(16)));
typedef unsigned u32x4 __attribute__((ext_vector_type(4)));
typedef unsigned u32x2 __attribute__((ext_vector_type(2)));
typedef short s16x4 __attribute__((ext_vector_type(4)));
typedef __bf16 bf16x2_t __attribute__((ext_vector_type(2)));

constexpr int DM = 1024, SEQ = 2048, NBATCH = 24, NB_PROMPT = 16, M = NBATCH * SEQ;
constexpr int NH = 8, HD = 64, FF = 4096, FW = 512;
constexpr int N1 = 5120;
constexpr float EPS = 1e-6f;
constexpr float LAMBDA_INIT = 0.2f;
constexpr float C2 = 0.125f * 1.4426950408889634f;

constexpr size_t MiB = 1u << 20;
constexpr size_t WS_CTL = 0;
constexpr size_t WS_SSQ = 1 * MiB;
constexpr size_t WS_WUP = 2 * MiB, WS_WDN = 10 * MiB;
constexpr size_t WS_XB = 18 * MiB;
constexpr size_t WS_QO = 114 * MiB;
constexpr size_t WS_K = 210 * MiB;
constexpr size_t WS_V = 306 * MiB;
constexpr size_t WS_FT = 402 * MiB;
constexpr size_t WS_W1 = 450 * MiB;
constexpr size_t WS_DFT = 461 * MiB;
constexpr size_t WS_WMIX = 477 * MiB;
constexpr size_t WS_WOUT = 481 * MiB;
constexpr size_t WS_ROPE = 483 * MiB;
constexpr size_t WS_U = 114 * MiB;
constexpr size_t WS_END = 498 * MiB;

constexpr int RING_BYTES = 131072;
constexpr int LDS_BYTES = 147456;

namespace pg8 {
constexpr int BM = 256, BK = 64, HALF = 128, HTB = HALF * BK * 2, NXCD = 8, WGM = 8;
__host__ __device__ __forceinline__ int lds_byte(int r, int c) { const int st = (r >> 4) * 2 + (c >> 5), rr = r & 15, cc = c & 31, ob = rr * 64 + cc * 2; return st * 1024 + (ob ^ (((ob >> 9) & 1) << 5)); }
__host__ __device__ __forceinline__ void stage_rc(int b, int& R, int& C) { const int st = b / 1024, sb = b % 1024, swz = sb ^ (((sb >> 9) & 1) << 5); R = (st >> 1) * 16 + swz / 64; C = (st & 1) * 32 + (swz % 64) / 2; }
__host__ __device__ __forceinline__ int perm32(int rho) { const int n = rho >> 4, i = rho & 15; return 8 * (i >> 2) + 4 * n + (i & 3); }

struct Unit { int pm, pn, pb; };
struct Gemm { const bf16_t* A; const bf16_t* Bt; int lda, ldb, K; size_t bsA, bsB; const bf16_t* A2; int ksplit; int hB, tB, adiv; const bf16_t* Bt2 = nullptr; };

struct StaticOrder {
    int nM, nN, nwg, G, c;
    __device__ void init(int nM_, int nN_, int nB_, int G_, int c_) { nM = nM_; nN = nN_; nwg = nM_ * nN_ * nB_; G = G_; c = c_; }
    __device__ bool next(int i, Unit& u) const {
        const long L = (long)i * G + c; if (L >= nwg) return false;
        int wgid = (int)L; { const int q = nwg / NXCD, r = nwg % NXCD, xcd = wgid % NXCD, off = wgid / NXCD; wgid = (xcd < r ? xcd * (q + 1) : r * (q + 1) + (xcd - r) * q) + off; }
        const int per = nM * nN; u.pb = wgid / per; const int id = wgid % per;
        const int nig = WGM * nN, gid = id / nig, fm = gid * WGM, gsz = (nM - fm) < WGM ? (nM - fm) : WGM;
        u.pm = fm + ((id % nig) % gsz); u.pn = (id % nig) / gsz; return true;
    }
};

__device__ __forceinline__ unsigned cvt_pk_bf16(float lo, float hi) { f32x2 v = {lo, hi}; bf16x2_t b = __builtin_convertvector(v, bf16x2_t); return __builtin_bit_cast(unsigned, b); }
__device__ __forceinline__ u32x4 pack8(const f32x4 a, const f32x4 b) { u32x4 w; w.x = cvt_pk_bf16(a[0], a[1]); w.y = cvt_pk_bf16(a[2], a[3]); w.z = cvt_pk_bf16(b[0], b[1]); w.w = cvt_pk_bf16(b[2], b[3]); return w; }
__device__ __forceinline__ void unpack8(const u32x4 w, f32x4& a, f32x4& b) {
    a[0] = __uint_as_float(w.x << 16); a[1] = __uint_as_float(w.x & 0xffff0000u); a[2] = __uint_as_float(w.y << 16); a[3] = __uint_as_float(w.y & 0xffff0000u);
    b[0] = __uint_as_float(w.z << 16); b[1] = __uint_as_float(w.z & 0xffff0000u); b[2] = __uint_as_float(w.w << 16); b[3] = __uint_as_float(w.w & 0xffff0000u); }

__device__ __forceinline__ float quad_sum(float v) {
    auto a = __builtin_amdgcn_permlane16_swap(__float_as_uint(v), __float_as_uint(v), false, false); v = __uint_as_float(a[0]) + __uint_as_float(a[1]);
    auto b = __builtin_amdgcn_permlane32_swap(__float_as_uint(v), __float_as_uint(v), false, false); return __uint_as_float(b[0]) + __uint_as_float(b[1]); }
typedef f32x4 Acc[2][2][4][2];

template <class Epi, bool ALIGN_EPI, bool SPLITA>
__device__ __forceinline__ void gemm_phase(LAS unsigned char* lds, const Gemm g, const StaticOrder& S, const Epi& E) {
    int tid = threadIdx.x; asm volatile("" : "+v"(tid));
    const int wid = __builtin_amdgcn_readfirstlane(tid >> 6), lane = tid & 63, wr = wid >> 2, wc = wid & 3, fr = lane & 15, fq = lane >> 4;
    const int K = g.K, nt = K / BK;
    unsigned voffA[2], voffB[2];
#pragma unroll
    for (int i = 0; i < 2; ++i) { int R, C; stage_rc(tid * 16 + i * 8192, R, C); const int Rb = (R & ~31) + perm32(R & 31);
        voffA[i] = (unsigned)(R * g.lda + C) * 2u; voffB[i] = (unsigned)(Rb * g.ldb + C) * 2u; }
    const size_t kstep = (size_t)(BK * 2);
    const size_t hstepA = (size_t)HALF * g.lda * 2, hstepB = (size_t)g.hB * g.ldb * 2;
    const size_t tstepA = 2 * hstepA, tstepB = (size_t)g.tB * g.ldb * 2;
    [[maybe_unused]] unsigned voffAm[2] = {0u, 0u};
    if constexpr (SPLITA) {
#pragma unroll
        for (int i = 0; i < 2; ++i) { int R, C; stage_rc(tid * 16 + i * 8192, R, C); voffAm[i] = (unsigned)((HALF - 1 - R) * g.lda + C) * 2u; }
    }
    auto kofs = [&](int t) -> size_t { if constexpr (Epi::KBLK) return (size_t)(t >> 2) * (BM * BM * 2) + (size_t)(t & 3) * kstep; else return (size_t)t * kstep; };
    auto mirrored = [&](const Unit& u) -> bool { return SPLITA && (u.pm & 4) != 0; };
    auto baseA1 = [&](const Unit& u) -> const char* {
        if (SPLITA && (u.pm & 4)) return (const char*)g.A + ((size_t)(u.pm & ~7) * BM + (size_t)(2048 - BM * (u.pm & 7) - (HALF - 1))) * g.lda * 2;
        if constexpr (Epi::KBLK) return (const char*)g.A + (size_t)u.pm * ((size_t)BM * g.K * 2);
        return (const char*)g.A + (size_t)u.pm * tstepA + (size_t)(u.pb / g.adiv) * g.bsA * 2; };
    auto baseB = [&](const Unit& u) -> const char* { return (const char*)g.Bt + (size_t)u.pn * tstepB + (size_t)u.pb * g.bsB * 2; };
    const unsigned ldsw = (unsigned)wid * 1024u;
    const int aoff = lds_byte(wr * 64 + fr, fq * 8), boff = lds_byte(wc * 32 + fr, fq * 8);
#define PG8_SA(b, h) (((b) * 2 + (h)) * HTB)
#define PG8_SB(b, h) ((4 + (b) * 2 + (h)) * HTB)
#define PG8_STAGE(bufoff, gbase, voff) do { _Pragma("unroll") for (int _i = 0; _i < 2; ++_i) \
        __builtin_amdgcn_global_load_lds((const unsigned*)((const char*)(gbase) + (voff)[_i]), (LAS unsigned*)(lds + (bufoff) + ldsw + _i * 8192), 16, 0, 0); } while (0)
#define PG8_LDA(dst, b, h) do { _Pragma("unroll") for (int m = 0; m < 4; ++m) _Pragma("unroll") for (int k = 0; k < 2; ++k) dst[m][k] = *(const LAS bf16x8*)(lds + PG8_SA(b, h) + aoff + m * 2048 + k * 1024); } while (0)
#define PG8_LDB(dst, b, h) do { _Pragma("unroll") for (int n = 0; n < 2; ++n) _Pragma("unroll") for (int k = 0; k < 2; ++k) dst[n][k] = *(const LAS bf16x8*)(lds + PG8_SB(b, h) + boff + n * 2048 + k * 1024); } while (0)
#define PG8_MMA(ai, bj, At, Bt) do { __builtin_amdgcn_s_setprio(1); _Pragma("unroll") for (int m = 0; m < 4; ++m) _Pragma("unroll") for (int n = 0; n < 2; ++n) _Pragma("unroll") for (int k = 0; k < 2; ++k) \
        acc[ai][bj][m][n] = __builtin_amdgcn_mfma_f32_16x16x32_bf16(Bt[n][k], At[m][k], acc[ai][bj][m][n], 0, 0, 0); __builtin_amdgcn_s_setprio(0); } while (0)
#define PG8_WAIT_V(n) asm volatile("s_waitcnt vmcnt(" #n ")" ::: "memory")
#define PG8_WAIT_L(n) asm volatile("s_waitcnt lgkmcnt(" #n ")" ::: "memory")
#define PG8_BAR __builtin_amdgcn_s_barrier()
#define PG8_SCHED __builtin_amdgcn_sched_barrier(0)
    Unit cur, nxt; int ui = 0;
    if (!S.next(0, cur)) return;
    Acc acc;
#pragma unroll
    for (int a = 0; a < 2; ++a)
#pragma unroll
        for (int b = 0; b < 2; ++b)
#pragma unroll
            for (int m = 0; m < 4; ++m)
#pragma unroll
                for (int n = 0; n < 2; ++n) acc[a][b][m][n] = (f32x4){0.f, 0.f, 0.f, 0.f};
    bf16x8 At[4][2], B0[2][2], B1[2][2];
    const char* cA = baseA1(cur); const char* cB = baseB(cur);
    const char* cA2 = SPLITA ? (const char*)g.A2 + (size_t)cur.pm * tstepA : cA;
    bool mirC = mirrored(cur);
    { const unsigned vo[2] = {mirC ? voffAm[0] : voffA[0], mirC ? voffAm[1] : voffA[1]}; const char* cAh = mirC ? cA - hstepA : cA + hstepA;
      PG8_STAGE(PG8_SB(0, 0), cB, voffB); PG8_STAGE(PG8_SB(0, 1), cB + hstepB, voffB); PG8_STAGE(PG8_SA(0, 0), cA, vo); PG8_STAGE(PG8_SA(0, 1), cAh, vo);
      if (wr == 1) PG8_BAR;
      PG8_WAIT_V(2); PG8_BAR;
      PG8_STAGE(PG8_SB(1, 0), cB + kstep, voffB); PG8_STAGE(PG8_SA(1, 0), cA + kofs(1), vo); PG8_STAGE(PG8_SB(1, 1), cB + hstepB + kstep, voffB); }
    PG8_WAIT_V(6); PG8_BAR;
    for (;;) {
        const bool has_next = S.next(ui + 1, nxt);
        const char* nA = has_next ? baseA1(nxt) : cA;
        const char* nB = has_next ? baseB(nxt) : cB;
        const bool mirN = has_next ? mirrored(nxt) : mirC;
        for (int t = 0; t < nt; t += 2) {
            const bool last = (t == nt - 2);
            if constexpr (SPLITA) {
                if (mirC && t == (g.ksplit >> 1)) {
#pragma unroll
                    for (int a = 0; a < 2; ++a)
#pragma unroll
                        for (int b = 0; b < 2; ++b)
#pragma unroll
                            for (int m = 0; m < 4; ++m)
#pragma unroll
                                for (int n = 0; n < 2; ++n) acc[a][b][m][n] = -acc[a][b][m][n]; } }
            if constexpr (Epi::MIDK) { if (t == g.ksplit) E.mid(acc, cur, wr, wc, fr, fq, mirC ? -1.0f : 1.0f); }
            const char *a1, *a2;
            if constexpr (SPLITA) {
                a1 = (t + 1 < g.ksplit) ? cA + (size_t)(t + 1) * kstep : cA2 + (size_t)(t + 1 - g.ksplit) * kstep;
                a2 = last ? nA : ((t + 2 < g.ksplit) ? cA + (size_t)(t + 2) * kstep : cA2 + (size_t)(t + 2 - g.ksplit) * kstep);
            } else { a1 = cA + kofs(t + 1); a2 = last ? nA : cA + kofs(t + 2); }
            const char* b2 = last ? nB : cB + (size_t)(t + 2) * kstep;
            const char* a3 = a2 + kstep; const char* b3 = b2 + kstep;
            const bool m1 = SPLITA && mirC && (t + 1 < g.ksplit), m2 = SPLITA && (last ? mirN : (mirC && (t + 2 < g.ksplit)));
            const unsigned vo1[2] = {m1 ? voffAm[0] : voffA[0], m1 ? voffAm[1] : voffA[1]}, vo2[2] = {m2 ? voffAm[0] : voffA[0], m2 ? voffAm[1] : voffA[1]};
            const char* a1h = m1 ? a1 - hstepA : a1 + hstepA; const char* a2h = m2 ? a2 - hstepA : a2 + hstepA;
            PG8_LDB(B0, 0, 0); PG8_LDB(B1, 0, 1); PG8_SCHED; PG8_LDA(At, 0, 0); PG8_STAGE(PG8_SA(1, 1), a1h, vo1);
            PG8_WAIT_V(8); PG8_WAIT_L(0); PG8_BAR; PG8_MMA(0, 0, At, B0); PG8_MMA(0, 1, At, B1); PG8_BAR; PG8_SCHED;
            PG8_LDA(At, 0, 1); PG8_STAGE(PG8_SB(0, 0), b2, voffB); PG8_STAGE(PG8_SB(0, 1), b2 + hstepB, voffB); PG8_STAGE(PG8_SA(0, 0), a2, vo2);
            PG8_WAIT_V(8); PG8_WAIT_L(0); PG8_BAR; PG8_MMA(1, 0, At, B0); PG8_MMA(1, 1, At, B1); PG8_BAR; PG8_SCHED;
            PG8_LDB(B0, 1, 0); PG8_LDB(B1, 1, 1); PG8_SCHED; PG8_LDA(At, 1, 0); PG8_STAGE(PG8_SA(0, 1), a2h, vo2);
            PG8_WAIT_V(8); PG8_WAIT_L(0); PG8_BAR; PG8_MMA(0, 0, At, B0); PG8_MMA(0, 1, At, B1); PG8_BAR; PG8_SCHED;
            PG8_LDA(At, 1, 1); PG8_STAGE(PG8_SB(1, 0), b3, voffB); PG8_STAGE(PG8_SB(1, 1), b3 + hstepB, voffB); PG8_STAGE(PG8_SA(1, 0), a3, vo2);
            PG8_WAIT_V(8); PG8_WAIT_L(0); PG8_BAR; PG8_MMA(1, 0, At, B0); PG8_MMA(1, 1, At, B1); PG8_BAR; PG8_SCHED;
        }
        if constexpr (ALIGN_EPI) { if (wr == 0) PG8_BAR; }
        E(acc, cur, wr, wc, fr, fq);
        if (!has_next) break;
#pragma unroll
        for (int a = 0; a < 2; ++a)
#pragma unroll
            for (int b = 0; b < 2; ++b)
#pragma unroll
                for (int m = 0; m < 4; ++m)
#pragma unroll
                    for (int n = 0; n < 2; ++n) acc[a][b][m][n] = (f32x4){0.f, 0.f, 0.f, 0.f};
        cur = nxt; cA = nA; cB = nB; mirC = mirN; if constexpr (SPLITA) cA2 = (const char*)g.A2 + (size_t)cur.pm * tstepA; ++ui;
        if constexpr (ALIGN_EPI) { if (wr == 1) PG8_BAR; }
    }
    PG8_WAIT_V(0);
    if constexpr (!ALIGN_EPI) { if (wr == 0) PG8_BAR; }
    PG8_BAR;
#undef PG8_SA
#undef PG8_SB
#undef PG8_STAGE
#undef PG8_LDA
#undef PG8_LDB
#undef PG8_MMA
#undef PG8_WAIT_V
#undef PG8_WAIT_L
#undef PG8_BAR
#undef PG8_SCHED
}

struct EpiFT {
    static constexpr bool KBLK = false; static constexpr bool MIDK = false;
    bf16_t* O;
    __device__ __forceinline__ void mid(Acc&, const Unit&, int, int, int, int) const {}
    __device__ __forceinline__ void operator()(const Acc& acc, const Unit& u, int wr, int wc, int fr, int fq) const {
        const int row0 = u.pm * BM + wr * 64 + fr, col0 = u.pb * 1024 + u.pn * 128 + wc * 32 + 8 * fq;
#pragma unroll
        for (int ai = 0; ai < 2; ++ai)
#pragma unroll
            for (int m = 0; m < 4; ++m) { bf16_t* rowp = O + (size_t)(row0 + ai * HALF + m * 16) * M + col0;
                *(u32x4*)(rowp) = pack8(acc[ai][0][m][0] + acc[ai][1][m][0], acc[ai][0][m][1] + acc[ai][1][m][1]);
                *(u32x4*)(rowp + NBATCH * 1024) = pack8(acc[ai][0][m][0] - acc[ai][1][m][0], acc[ai][0][m][1] - acc[ai][1][m][1]); }
    }
};
struct EpiDft {
    static constexpr bool KBLK = false; static constexpr bool MIDK = false;
    bf16_t* O;
    __device__ __forceinline__ void mid(Acc&, const Unit&, int, int, int, int) const {}
    __device__ __forceinline__ void operator()(const Acc& acc, const Unit& u, int wr, int wc, int fr, int fq) const {
        const int parity = u.pb / NBATCH, batch = u.pb - parity * NBATCH;
        const int r0 = u.pm * BM + wr * 64 + fr, col0 = u.pn * BM + wc * 32 + 8 * fq;
        bf16_t* base0 = O + (size_t)batch * SEQ * DM + col0;
#pragma unroll
        for (int ai = 0; ai < 2; ++ai)
#pragma unroll
            for (int m = 0; m < 4; ++m) { const int r = r0 + ai * HALF + m * 16, pq = r >> 9, k = 2 * (r & 511) + parity;
                bf16_t* base = base0 + pq * 512;
#pragma unroll
                for (int bj = 0; bj < 2; ++bj) { const u32x4 w = pack8(acc[ai][bj][m][0], acc[ai][bj][m][1]);
                    if (k != 0) { *(u32x4*)(base + (size_t)k * DM + bj * HALF) = w; }
                    else if (pq == 0) { *(u32x4*)(base + bj * HALF) = w; }
                    else { *(u32x4*)(base - 512 + (size_t)1024 * DM + bj * HALF) = w;
                           const u32x4 z = {0u, 0u, 0u, 0u}; *(u32x4*)(base + bj * HALF) = z; *(u32x4*)(base + (size_t)1024 * DM + bj * HALF) = z; } } }
    }
};
struct EpiG1 {
    static constexpr bool KBLK = false; static constexpr bool MIDK = false;
    bf16_t *QO, *KB, *VB, *G0; const float *ropec, *ropes; const LAS float* cst;
    __device__ __forceinline__ void mid(Acc&, const Unit&, int, int, int, int) const {}
    __device__ __forceinline__ void operator()(const Acc& acc, const Unit& u, int wr, int wc, int fr, int fq) const {
        const int row0 = u.pm * BM + wr * 64 + fr; const int pn = u.pn;
        if (pn < 8) {
            const bool isq = pn < 4; const int hm = 4 * (pn & 3) + wc; bf16_t* dst = (isq ? QO : KB) + hm * 64 + 8 * fq; const LAS float* g = cst + 2048 + (isq ? 0 : 64) + 8 * fq;
            const float sc = isq ? C2 : 1.0f;
            const f32x4 gl0 = *(const LAS f32x4*)(g), gl1 = *(const LAS f32x4*)(g + 4), gh0 = *(const LAS f32x4*)(g + 32), gh1 = *(const LAS f32x4*)(g + 36);
            const f32x4 k0 = *(const LAS f32x4*)(cst + 2176 + 8 * fq), k1 = *(const LAS f32x4*)(cst + 2176 + 8 * fq + 4);
            const f32x4 t0 = *(const LAS f32x4*)(cst + 2208 + 8 * fq), t1 = *(const LAS f32x4*)(cst + 2208 + 8 * fq + 4);
#pragma unroll
            for (int ai = 0; ai < 2; ++ai) {
                const int sb = (row0 + ai * HALF) & (SEQ - 1);
                f32x4 c0 = *(const f32x4*)(ropec + sb * 32 + 8 * fq), c1 = *(const f32x4*)(ropec + sb * 32 + 8 * fq + 4);
                f32x4 s0 = *(const f32x4*)(ropes + sb * 32 + 8 * fq), s1 = *(const f32x4*)(ropes + sb * 32 + 8 * fq + 4);
#pragma unroll
                for (int m = 0; m < 4; ++m) {
                    const int row = row0 + ai * HALF + m * 16;
                    if (m > 0) { const f32x4 nc0 = c0 * k0 - s0 * t0, ns0 = s0 * k0 + c0 * t0, nc1 = c1 * k1 - s1 * t1, ns1 = s1 * k1 + c1 * t1; c0 = nc0; s0 = ns0; c1 = nc1; s1 = ns1; }
                    const f32x4 a0 = acc[ai][0][m][0], a1 = acc[ai][0][m][1], b0 = acc[ai][1][m][0], b1 = acc[ai][1][m][1];
                    f32x4 q2 = a0 * a0 + a1 * a1 + b0 * b0 + b1 * b1; float ss = (q2[0] + q2[1]) + (q2[2] + q2[3]);
                    ss = quad_sum(ss);
                    const float rinv = __builtin_amdgcn_rsqf(ss * (1.0f / 64.0f) + EPS) * sc;
                    const f32x4 y00 = a0 * rinv * gl0, y01 = a1 * rinv * gl1, y10 = b0 * rinv * gh0, y11 = b1 * rinv * gh1;
                    const f32x4 o00 = y00 * c0 - y10 * s0, o01 = y01 * c1 - y11 * s1, o10 = y10 * c0 + y00 * s0, o11 = y11 * c1 + y01 * s1;
                    bf16_t* rowp = dst + (size_t)row * DM;
                    *(u32x4*)(rowp) = pack8(o00, o01); *(u32x4*)(rowp + 32) = pack8(o10, o11);
                }
                asm volatile("" ::: "memory");
            }
        } else if (pn < 12) {
            const int col0 = (pn - 8) * BM + wc * 32 + 8 * fq;
#pragma unroll
            for (int ai = 0; ai < 2; ++ai)
#pragma unroll
                for (int m = 0; m < 4; ++m) { bf16_t* rowp = VB + (size_t)(row0 + ai * HALF + m * 16) * DM + col0;
#pragma unroll
                    for (int bj = 0; bj < 2; ++bj) *(u32x4*)(rowp + bj * HALF) = pack8(acc[ai][bj][m][0], acc[ai][bj][m][1]); }
        } else {
            const int col0 = (pn - 12) * 128 + wc * 32 + 8 * fq;
            const f32x4 ba0 = *(const LAS f32x4*)(cst + col0), ba1 = *(const LAS f32x4*)(cst + col0 + 4), bb0 = *(const LAS f32x4*)(cst + 1024 + col0), bb1 = *(const LAS f32x4*)(cst + 1024 + col0 + 4);
            const float NL2E = -1.4426950408889634f;
#pragma unroll
            for (int ai = 0; ai < 2; ++ai)
#pragma unroll
                for (int m = 0; m < 4; ++m) {
                    const int grow = row0 + ai * HALF + m * 16;
                    const size_t off = (size_t)(grow >> 8) * (BM * DM) + (size_t)(col0 >> 7) * (BM * 128) + (size_t)(grow & (BM - 1)) * 128 + (col0 & 127);
                    f32x4 z0[2] = {acc[ai][0][m][0] + ba0, acc[ai][0][m][1] + ba1}, z1[2] = {acc[ai][1][m][0] + bb0, acc[ai][1][m][1] + bb1};
                    u32x4 w = {0u, 0u, 0u, 0u}; const float C255 = 1.0f / 255.0f;
#pragma unroll
                    for (int n = 0; n < 2; ++n)
#pragma unroll
                        for (int e = 0; e < 4; ++e) {
                            const float e0 = __builtin_amdgcn_exp2f(fminf(z0[n][e] * NL2E, 40.f)), e1 = __builtin_amdgcn_exp2f(fminf(z1[n][e] * NL2E, 40.f));
                            const float q0 = fmaxf(__builtin_amdgcn_rcpf(__builtin_fmaf(e0, C255, C255)) + 0.5f, 1.0f), q1 = __builtin_amdgcn_rcpf(__builtin_fmaf(e1, C255, C255)) + 0.5f;
                            w[n] = __builtin_amdgcn_cvt_pk_u8_f32(q0, (unsigned)e, w[n]); w[2 + n] = __builtin_amdgcn_cvt_pk_u8_f32(q1, (unsigned)e, w[2 + n]); }
                    *(u32x4*)(G0 + off) = w;
                }
        }
    }
};
struct EpiMix {
    static constexpr bool KBLK = false; static constexpr bool MIDK = true;
    const bf16_t* G0; bf16_t* O;
    template <int MODE> __device__ __forceinline__ void scale(Acc& acc, const Unit& u, int wr, int wc, int fr, int fq, float sg = 1.0f) const {
        int row0 = u.pm * BM + wr * 64 + fr; const int col0 = u.pn * BM + wc * 32 + 8 * fq;
        asm volatile("" : "+v"(row0));
        u32x4 gv[2][4][2];
#pragma unroll
        for (int ai = 0; ai < 2; ++ai)
#pragma unroll
            for (int m = 0; m < 4; ++m)
#pragma unroll
                for (int bj = 0; bj < 2; ++bj) { const int grow = row0 + ai * HALF + m * 16, gcol = col0 + bj * HALF;
                    const bf16_t* gp = G0 + (size_t)(grow >> 8) * (BM * DM) + (size_t)(gcol >> 7) * (BM * 128) + (size_t)(grow & (BM - 1)) * 128 + (gcol & 127);
                    if (MODE == 0) gv[ai][m][bj] = *(const u32x4*)gp;
                    else { const u32x2 h = *(const u32x2*)gp; gv[ai][m][bj] = (u32x4){h.x, h.y, 0u, 0u}; } }
        asm volatile("" ::: "memory");
#pragma unroll
        for (int ai = 0; ai < 2; ++ai)
#pragma unroll
            for (int m = 0; m < 4; ++m)
#pragma unroll
                for (int bj = 0; bj < 2; ++bj)
#pragma unroll
                    for (int n = 0; n < 2; ++n)
#pragma unroll
                        for (int e = 0; e < 4; ++e) { const float q0 = (float)((gv[ai][m][bj][n] >> (8 * e)) & 255u);
                            if (MODE == 0) { const float q1 = (float)((gv[ai][m][bj][2 + n] >> (8 * e)) & 255u); acc[ai][bj][m][n][e] *= (q1 * sg) * __builtin_amdgcn_rcpf(q0); }
                            else acc[ai][bj][m][n][e] *= q0 * (1.0f / 255.0f); }
        asm volatile("" ::: "memory");
    }
    __device__ __forceinline__ void mid(Acc& acc, const Unit& u, int wr, int wc, int fr, int fq, float sg) const { scale<0>(acc, u, wr, wc, fr, fq, sg); }
    __device__ __forceinline__ void operator()(Acc& acc, const Unit& u, int wr, int wc, int fr, int fq) const {
        scale<1>(acc, u, wr, wc, fr, fq);
        const int row0 = u.pm * BM + wr * 64 + fr, col0 = u.pn * BM + wc * 32 + 8 * fq;
#pragma unroll
        for (int ai = 0; ai < 2; ++ai)
#pragma unroll
            for (int m = 0; m < 4; ++m) { bf16_t* rowp = O + (size_t)u.pm * (BM * DM) + (size_t)u.pn * (BM * BM) + (size_t)((row0 + ai * HALF + m * 16) & (BM - 1)) * BM + (col0 & (BM - 1));
#pragma unroll
                for (int bj = 0; bj < 2; ++bj) *(u32x4*)(rowp + bj * HALF) = pack8(acc[ai][bj][m][0], acc[ai][bj][m][1]); }
    }
};
struct EpiOut {
    static constexpr bool KBLK = true;  static constexpr bool MIDK = false;
    const float* xn; bf16_t* X1B; float* ssq;
    __device__ __forceinline__ void mid(Acc&, const Unit&, int, int, int, int) const {}
    __device__ __forceinline__ void operator()(const Acc& acc, const Unit& u, int wr, int wc, int fr, int fq) const {
        const int row0 = u.pm * BM + wr * 64 + fr, col0 = u.pn * BM + wc * 32 + 8 * fq;
#pragma unroll
        for (int ai = 0; ai < 2; ++ai) {
            u32x4 xw[4][2]; float nr[4];
#pragma unroll
            for (int m = 0; m < 4; ++m) { nr[m] = xn[row0 + ai * HALF + m * 16];
#pragma unroll
                for (int bj = 0; bj < 2; ++bj) xw[m][bj] = *(const u32x4*)(X1B + (size_t)(row0 + ai * HALF + m * 16) * DM + col0 + bj * HALF); }
#pragma unroll
            for (int m = 0; m < 4; ++m) {
                const int row = row0 + ai * HALF + m * 16; const size_t off = (size_t)row * DM + col0; float ss = 0.f;
#pragma unroll
                for (int bj = 0; bj < 2; ++bj) {
                    f32x4 xa, xb2; unpack8(xw[m][bj], xa, xb2);
                    const f32x4 v0 = xa * nr[m] + acc[ai][bj][m][0], v1 = xb2 * nr[m] + acc[ai][bj][m][1];
                    *(u32x4*)(X1B + off + bj * HALF) = pack8(v0, v1);
                    const f32x4 q = v0 * v0 + v1 * v1; ss += (q[0] + q[1]) + (q[2] + q[3]); }
                ss = quad_sum(ss);
                if (fq == 0) atomicAdd(ssq + row, ss);
            }
            asm volatile("" ::: "memory");
        }
    }
};
struct EpiUp {
    static constexpr bool KBLK = false; static constexpr bool MIDK = false;
    const float* ssq; bf16_t* U;
    __device__ __forceinline__ void mid(Acc&, const Unit&, int, int, int, int) const {}
    __device__ __forceinline__ void operator()(const Acc& acc, const Unit& u, int wr, int wc, int fr, int fq) const {
        const int row0 = u.pm * BM + wr * 64 + fr, col0 = u.pn * BM + wc * 32 + 8 * fq;
#pragma unroll
        for (int ai = 0; ai < 2; ++ai)
#pragma unroll
            for (int m = 0; m < 4; ++m) {
                const int row = row0 + ai * HALF + m * 16; const float rinv = __builtin_amdgcn_rsqf(ssq[row] * (1.0f / DM) + EPS);
                bf16_t* rowp = U + (size_t)u.pm * (BM * FF) + (size_t)u.pn * (BM * BM) + (size_t)(row & (BM - 1)) * BM + (col0 & (BM - 1));
#pragma unroll
                for (int bj = 0; bj < 2; ++bj) { f32x4 v0 = acc[ai][bj][m][0] * rinv, v1 = acc[ai][bj][m][1] * rinv;
#pragma unroll
                    for (int e = 0; e < 4; ++e) { const float a = fmaxf(v0[e], 0.f), b = fmaxf(v1[e], 0.f); v0[e] = a * a; v1[e] = b * b; }
                    *(u32x4*)(rowp + bj * HALF) = pack8(v0, v1); }
            }
    }
};
struct EpiDown {
    static constexpr bool KBLK = true; static constexpr bool MIDK = false;
    float* out; const bf16_t* X1B;
    __device__ __forceinline__ void mid(Acc&, const Unit&, int, int, int, int) const {}
    __device__ __forceinline__ void operator()(const Acc& acc, const Unit& u, int wr, int wc, int fr, int fq) const {
        const int row0 = u.pm * BM + wr * 64 + fr, col0 = u.pn * BM + wc * 32 + 8 * fq;
#pragma unroll
        for (int ai = 0; ai < 2; ++ai) {
            u32x4 xv[4][2];
#pragma unroll
            for (int m = 0; m < 4; ++m)
#pragma unroll
                for (int bj = 0; bj < 2; ++bj) xv[m][bj] = *(const u32x4*)(X1B + (size_t)(row0 + ai * HALF + m * 16) * DM + col0 + bj * HALF);
#pragma unroll
            for (int m = 0; m < 4; ++m)
#pragma unroll
                for (int bj = 0; bj < 2; ++bj) { float* rowp = out + (size_t)(row0 + ai * HALF + m * 16) * DM + col0 + bj * HALF; f32x4 a, b; unpack8(xv[m][bj], a, b);
                    *(f32x4*)(rowp) = a + acc[ai][bj][m][0]; *(f32x4*)(rowp + 4) = b + acc[ai][bj][m][1]; }
            asm volatile("" ::: "memory");
        }
    }
};
}

namespace att {
constexpr int KVBLK = 64, NT = SEQ / KVBLK, QB = 256;
constexpr int KSLOT = 8192, VSLOT = 16384, NSLOT = 3;
constexpr int LDS_K = 0, LDS_V = NSLOT * KSLOT, LDS_ST = LDS_V + NSLOT * VSLOT, LDS_WS = LDS_ST + 8 * 8192, LDS_END = LDS_WS + 8 * 256;
static_assert(LDS_END <= RING_BYTES + 12288, "attention LDS");
typedef LAS const char* lds_cptr;
typedef short v4i16_t __attribute__((ext_vector_type(4)));
__device__ __forceinline__ int crow(int r, int hi) { return (r & 3) + 8 * (r >> 2) + 4 * hi; }
__device__ __forceinline__ void glds16(const void* gsrc, unsigned lds_dst) { unsigned keep;
    asm volatile("s_mov_b32 %0, m0\n\ts_mov_b32 m0, %2\n\ts_nop 0\n\tglobal_load_lds_dwordx4 %1, off\n\ts_mov_b32 m0, %0" : "=&s"(keep) : "v"(gsrc), "s"(lds_dst) : "memory"); }
__device__ __forceinline__ s16x4 vtr(lds_cptr p) { return __builtin_bit_cast(s16x4, __builtin_amdgcn_ds_read_tr16_b64_v4i16((LAS v4i16_t*)p)); }
__device__ __forceinline__ void kload2(bf16x8* kf, lds_cptr kp, int j) { kf[2 * j] = *(const LAS bf16x8*)(kp + j * 2048); kf[2 * j + 1] = *(const LAS bf16x8*)(kp + j * 2048 + 512); }
#define ATT_WAIT_BAR(N) asm volatile("s_waitcnt vmcnt(" #N ") lgkmcnt(0)\n\ts_barrier" ::: "memory")
#define ATT_SB() __builtin_amdgcn_sched_barrier(0)
#define ATT_PIN(x) asm volatile("" : "+v"(x))
#define ATT_MFMA(a, b, c) __builtin_amdgcn_mfma_f32_32x32x16_bf16(a, b, c, 0, 0, 0)
#define ATT_PK(lo, hi) pg8::cvt_pk_bf16(lo, hi)

__device__ __forceinline__ void attn_unit(int b, int h, int qb, bool first, bool has_next, int nb, int nh, bf16_t* QO, const bf16_t* __restrict__ K, const bf16_t* __restrict__ V, float lam, char* shm) {
    int tid = threadIdx.x; asm volatile("" : "+v"(tid));
    const int lane = tid & 63, r32 = lane & 31, hi = lane >> 5; const int wid = __builtin_amdgcn_readfirstlane(tid >> 6);
    const long rowbase = (long)b * SEQ; const int q0 = qb * QB;
    const unsigned lds0 = (unsigned)(uintptr_t)shm;
    const long klane = (long)lane * DM + wid * 8;
    const long vlane = (long)(16 * (wid & 3) + (lane >> 2)) * DM + (wid >> 2) * 32 + (lane & 3) * 8;
    const bf16_t* vsrc0 = V + rowbase * DM + h * 128 + vlane;
    const unsigned vdst = lds0 + LDS_V + wid * 1024, kdst = lds0 + LDS_K + wid * 1024;
    const lds_cptr shm3 = (lds_cptr)shm;
    const lds_cptr vp0 = shm3 + LDS_V + ((lane >> 4) & 1) * 32 + (lane & 3) * 8 + (4 * hi + ((lane & 15) >> 2)) * 64;
    const lds_cptr kp0 = shm3 + LDS_K + hi * 1024 + r32 * 16;
    f32x16 o[4];
#pragma unroll 1
    for (int map = 0; map < 2; ++map) {
        const int hm = 2 * h + map;
        const bf16_t* ksrc = K + rowbase * DM + hm * 64 + klane;
        const bf16_t* Qw = QO + (rowbase + q0 + wid * 32) * DM + hm * 64;
        bf16x8 qr[4];
#pragma unroll
        for (int d0 = 0; d0 < 4; ++d0) qr[d0] = *reinterpret_cast<const bf16x8*>(&Qw[(long)r32 * DM + d0 * 16 + hi * 8]);
#define DMA_K(t, slot) glds16(ksrc + (long)(t) * KVBLK * DM, (unsigned)__builtin_amdgcn_readfirstlane(kdst + (slot) * KSLOT))
#define DMA_V(t, slot) do { glds16(vsrc0 + (long)(t) * KVBLK * DM, (unsigned)__builtin_amdgcn_readfirstlane(vdst + (slot) * VSLOT)); \
        glds16(vsrc0 + (long)(t) * KVBLK * DM + 64, (unsigned)__builtin_amdgcn_readfirstlane(vdst + (slot) * VSLOT + 8192)); } while (0)
        if (map == 0 && first) { DMA_K(0, 0); DMA_V(0, 0); DMA_K(1, 1); DMA_K(2, 2); }
        float l_reg = 0.f;
#pragma unroll
        for (int d0 = 0; d0 < 4; ++d0) o[d0] = f32x16{};
        f32x16 pA0, pA1, pB0, pB1; bf16x8 kf[8]; s16x4 vlo[4], vhi[4]; u32x4 pw0, pw1, pw2, pw3;
        int sl_prev = 0, sl_cur = 0, sl_next = 1;
#define ROT() do { sl_prev = sl_cur; sl_cur = sl_next; sl_next = (sl_next == 2) ? 0 : sl_next + 1; } while (0)
        ATT_WAIT_BAR(4);
        { const lds_cptr kp = kp0; pA0 = f32x16{}; pA1 = f32x16{};
#pragma unroll
          for (int d0 = 0; d0 < 4; ++d0) { const bf16x8 k0 = *(const LAS bf16x8*)(kp + d0 * 2048), k1 = *(const LAS bf16x8*)(kp + d0 * 2048 + 512);
              pA0 = ATT_MFMA(k0, qr[d0], pA0); pA1 = ATT_MFMA(k1, qr[d0], pA1); }
#pragma unroll
          for (int r = 0; r < 16; ++r) { pA0[r] = __builtin_amdgcn_exp2f(pA0[r]); pA1[r] = __builtin_amdgcn_exp2f(pA1[r]); }
          ATT_PIN(pA0); ATT_PIN(pA1); }
        ATT_SB();
        ATT_WAIT_BAR(0);
        DMA_K(3, 0); DMA_V(1, 1);
        ROT();
#pragma unroll
        for (int j = 0; j < 4; ++j) kload2(kf, kp0 + sl_cur * KSLOT, j);
        ATT_WAIT_BAR(3);
#define VOFF(j) ((((j) & 3) * 4096) + (((j) >> 2) * 1024))
#define VRD(j) do { vlo[(j) & 3] = vtr(vp_ + VOFF(j)); vhi[(j) & 3] = vtr(vp_ + VOFF(j) + 512); } while (0)
#define VFR(j) (bf16x8){vlo[(j) & 3][0], vlo[(j) & 3][1], vlo[(j) & 3][2], vlo[(j) & 3][3], vhi[(j) & 3][0], vhi[(j) & 3][1], vhi[(j) & 3][2], vhi[(j) & 3][3]}
#define PAF(k) __builtin_bit_cast(bf16x8, pw##k)
#define EX(v) __builtin_amdgcn_exp2f(v)
#define GAPA(MF, A0, A1, A2, A3, W0, W1, PW) do { MF; sacc += A0; sacc += A1; sacc += A2; sacc += A3; ATT_PIN(sacc); W0; W1; ATT_PIN(PW); ATT_SB(); } while (0)
#define GAPB(MF, X, B, RD) do { MF; X[B] = EX(X[B]); X[B + 1] = EX(X[B + 1]); ATT_PIN(X); RD; ATT_SB(); } while (0)
#define KRD(G, j) do { if (G) { kload2(kf, kp0 + sl_next * KSLOT, j); } } while (0)
#define NOP_ do { } while (0)
#define STEP(C0, C1, P0, P1, t, GK, GV, GL) do { ATT_SB(); \
        const lds_cptr vp_ = vp0 + sl_prev * VSLOT; \
        VRD(0); ATT_SB(); float sacc = (P0[0] + P0[1]); \
        GAPA(C0 = ATT_MFMA(kf[0], qr[0], (f32x16{})), P0[2], P0[3], P0[4], P0[5],     pw0[0] = ATT_PK(P0[0], P0[1]),   pw0[1] = ATT_PK(P0[2], P0[3]),   pw0); \
        VRD(1); ATT_SB(); GAPA(C1 = ATT_MFMA(kf[1], qr[0], (f32x16{})), P0[6], P0[7], P0[8], P0[9],     pw0[2] = ATT_PK(P0[4], P0[5]),   pw0[3] = ATT_PK(P0[6], P0[7]),   pw0); \
        VRD(2); ATT_SB(); GAPA(C0 = ATT_MFMA(kf[2], qr[1], C0),          P0[10], P0[11], P0[12], P0[13], pw1[0] = ATT_PK(P0[8], P0[9]),   pw1[1] = ATT_PK(P0[10], P0[11]), pw1); \
        VRD(3); ATT_SB(); GAPA(C1 = ATT_MFMA(kf[3], qr[1], C1),          P0[14], P0[15], P1[0], P1[1],   pw1[2] = ATT_PK(P0[12], P0[13]), pw1[3] = ATT_PK(P0[14], P0[15]), pw1); \
        GAPA(C0 = ATT_MFMA(kf[4], qr[2], C0),          P1[2], P1[3], P1[4], P1[5],     pw2[0] = ATT_PK(P1[0], P1[1]),   pw2[1] = ATT_PK(P1[2], P1[3]),   pw2); \
        GAPA(C1 = ATT_MFMA(kf[5], qr[2], C1),          P1[6], P1[7], P1[8], P1[9],     pw2[2] = ATT_PK(P1[4], P1[5]),   pw2[3] = ATT_PK(P1[6], P1[7]),   pw2); \
        GAPA(C0 = ATT_MFMA(kf[6], qr[3], C0),          P1[10], P1[11], P1[12], P1[13], pw3[0] = ATT_PK(P1[8], P1[9]),   pw3[1] = ATT_PK(P1[10], P1[11]), pw3); \
        GAPA(C1 = ATT_MFMA(kf[7], qr[3], C1),          P1[14], P1[15], 0.f, 0.f,       pw3[2] = ATT_PK(P1[12], P1[13]), pw3[3] = ATT_PK(P1[14], P1[15]), pw3); \
        l_reg += sacc; \
        if (GK) { DMA_K((t) + 3, sl_cur); } if (GV) { DMA_V((t) + 1, sl_next); } \
        ATT_SB(); \
        GAPB(o[0] = ATT_MFMA(PAF(0), VFR(0), o[0]),   C0, 0,  VRD(4)); \
        GAPB(o[1] = ATT_MFMA(PAF(0), VFR(1), o[1]),   C0, 2,  VRD(5)); \
        GAPB(o[2] = ATT_MFMA(PAF(0), VFR(2), o[2]),   C0, 4,  VRD(6)); \
        GAPB(o[3] = ATT_MFMA(PAF(0), VFR(3), o[3]),   C0, 6,  VRD(7)); \
        GAPB(o[0] = ATT_MFMA(PAF(1), VFR(4), o[0]),   C0, 8,  VRD(8)); \
        GAPB(o[1] = ATT_MFMA(PAF(1), VFR(5), o[1]),   C0, 10, VRD(9)); \
        KRD(GL, 0); GAPB(o[2] = ATT_MFMA(PAF(1), VFR(6), o[2]),   C0, 12, VRD(10)); \
        GAPB(o[3] = ATT_MFMA(PAF(1), VFR(7), o[3]),   C0, 14, VRD(11)); \
        KRD(GL, 1); GAPB(o[0] = ATT_MFMA(PAF(2), VFR(8), o[0]),   C1, 0,  VRD(12)); \
        GAPB(o[1] = ATT_MFMA(PAF(2), VFR(9), o[1]),   C1, 2,  VRD(13)); \
        KRD(GL, 2); GAPB(o[2] = ATT_MFMA(PAF(2), VFR(10), o[2]),  C1, 4,  VRD(14)); \
        GAPB(o[3] = ATT_MFMA(PAF(2), VFR(11), o[3]),  C1, 6,  VRD(15)); \
        KRD(GL, 3); GAPB(o[0] = ATT_MFMA(PAF(3), VFR(12), o[0]),  C1, 8,  NOP_); \
        GAPB(o[1] = ATT_MFMA(PAF(3), VFR(13), o[1]),  C1, 10, NOP_); \
        GAPB(o[2] = ATT_MFMA(PAF(3), VFR(14), o[2]),  C1, 12, NOP_); \
        GAPB(o[3] = ATT_MFMA(PAF(3), VFR(15), o[3]),  C1, 14, NOP_); \
        } while (0)
        int t = 1;
#pragma unroll 1
        for (; t + 1 <= NT - 4; t += 2) {
            STEP(pB0, pB1, pA0, pA1, t, true, true, true);     ATT_WAIT_BAR(3); ROT();
            STEP(pA0, pA1, pB0, pB1, t + 1, true, true, true); ATT_WAIT_BAR(3); ROT();
        }
        STEP(pB0, pB1, pA0, pA1, NT - 3, false, true, true);   ATT_WAIT_BAR(2); ROT();
        STEP(pA0, pA1, pB0, pB1, NT - 2, false, true, true);   ATT_WAIT_BAR(0); ROT();
        STEP(pB0, pB1, pA0, pA1, NT - 1, false, false, false);
        { float sacc = pB0[0] + pB0[1];
#pragma unroll
          for (int r = 2; r < 16; ++r) sacc += pB0[r];
#pragma unroll
          for (int r = 0; r < 16; ++r) sacc += pB1[r];
          l_reg += sacc;
          pw0 = (u32x4){ATT_PK(pB0[0], pB0[1]), ATT_PK(pB0[2], pB0[3]), ATT_PK(pB0[4], pB0[5]), ATT_PK(pB0[6], pB0[7])};
          pw1 = (u32x4){ATT_PK(pB0[8], pB0[9]), ATT_PK(pB0[10], pB0[11]), ATT_PK(pB0[12], pB0[13]), ATT_PK(pB0[14], pB0[15])};
          pw2 = (u32x4){ATT_PK(pB1[0], pB1[1]), ATT_PK(pB1[2], pB1[3]), ATT_PK(pB1[4], pB1[5]), ATT_PK(pB1[6], pB1[7])};
          pw3 = (u32x4){ATT_PK(pB1[8], pB1[9]), ATT_PK(pB1[10], pB1[11]), ATT_PK(pB1[12], pB1[13]), ATT_PK(pB1[14], pB1[15])};
          ATT_SB();
          const lds_cptr vp = vp0 + sl_cur * VSLOT;
#pragma unroll
          for (int d0 = 0; d0 < 4; ++d0) {
              const s16x4 l0 = vtr(vp + d0 * 4096), h0 = vtr(vp + d0 * 4096 + 512), l1 = vtr(vp + d0 * 4096 + 1024), h1 = vtr(vp + d0 * 4096 + 1536);
              const s16x4 l2 = vtr(vp + d0 * 4096 + 2048), h2 = vtr(vp + d0 * 4096 + 2560), l3 = vtr(vp + d0 * 4096 + 3072), h3 = vtr(vp + d0 * 4096 + 3584);
              o[d0] = ATT_MFMA(PAF(0), ((bf16x8){l0[0], l0[1], l0[2], l0[3], h0[0], h0[1], h0[2], h0[3]}), o[d0]);
              o[d0] = ATT_MFMA(PAF(1), ((bf16x8){l1[0], l1[1], l1[2], l1[3], h1[0], h1[1], h1[2], h1[3]}), o[d0]);
              o[d0] = ATT_MFMA(PAF(2), ((bf16x8){l2[0], l2[1], l2[2], l2[3], h2[0], h2[1], h2[2], h2[3]}), o[d0]);
              o[d0] = ATT_MFMA(PAF(3), ((bf16x8){l3[0], l3[1], l3[2], l3[3], h3[0], h3[1], h3[2], h3[3]}), o[d0]); } }
#undef STEP
#undef GAPA
#undef GAPB
#undef KRD
#undef NOP_
#undef VRD
#undef VFR
#undef VOFF
#undef PAF
#undef EX
#undef ROT
#undef DMA_K
#undef DMA_V
        ATT_SB();
        asm volatile("s_waitcnt lgkmcnt(0)\n\ts_barrier" ::: "memory");
        ATT_SB();
        if (map == 0 || has_next) {
            const bf16_t* nk = (map == 0) ? ksrc + 64 : K + (long)nb * SEQ * DM + (2 * nh) * 64 + klane;
            const bf16_t* nv = (map == 0) ? vsrc0 : V + (long)nb * SEQ * DM + nh * 128 + vlane;
            glds16(nk, (unsigned)__builtin_amdgcn_readfirstlane(kdst)); glds16(nv, (unsigned)__builtin_amdgcn_readfirstlane(vdst)); glds16(nv + 64, (unsigned)__builtin_amdgcn_readfirstlane(vdst + 8192));
            glds16(nk + (long)KVBLK * DM, (unsigned)__builtin_amdgcn_readfirstlane(kdst + KSLOT)); glds16(nk + 2L * KVBLK * DM, (unsigned)__builtin_amdgcn_readfirstlane(kdst + 2 * KSLOT)); }
        ATT_SB();
        { auto rr = __builtin_amdgcn_permlane32_swap(__float_as_uint(l_reg), __float_as_uint(l_reg), false, false); l_reg = __uint_as_float(rr[0]) + __uint_as_float(rr[1]); }
        int elane = lane; asm volatile("" : "+v"(elane));
        const int er32 = elane & 31, ehi = elane >> 5;
        float* wsf = (float*)(shm + LDS_WS) + wid * 64;
        u32x4* stash = (u32x4*)(shm + LDS_ST + wid * 8192);
        if (ehi == 0) wsf[er32] = l_reg;
        asm volatile("s_waitcnt lgkmcnt(0)" ::: "memory");
        float rli[16];
#pragma unroll
        for (int r = 0; r < 16; ++r) rli[r] = __builtin_amdgcn_rcpf(wsf[crow(r, ehi)]);
        asm volatile("s_waitcnt lgkmcnt(0)" ::: "memory");
        if (map == 0) {
#pragma unroll
            for (int d0 = 0; d0 < 4; ++d0)
#pragma unroll
                for (int i = 0; i < 2; ++i) { u32x4 w;
#pragma unroll
                    for (int j = 0; j < 4; ++j) { const int r = 8 * i + 2 * j; w[j] = pg8::cvt_pk_bf16(o[d0][r] * rli[r], o[d0][r + 1] * rli[r + 1]); }
                    stash[(d0 * 2 + i) * 64 + elane] = w; }
        } else {
            float ssr[16];
#pragma unroll
            for (int r = 0; r < 16; ++r) ssr[r] = 0.f;
#pragma unroll
            for (int d0 = 0; d0 < 4; ++d0)
#pragma unroll
                for (int i = 0; i < 2; ++i) { const u32x4 w = stash[(d0 * 2 + i) * 64 + elane];
#pragma unroll
                    for (int j = 0; j < 4; ++j) { const int r = 8 * i + 2 * j;
                        const float a = __uint_as_float(w[j] << 16) - lam * (o[d0][r] * rli[r]), c = __uint_as_float(w[j] & 0xffff0000u) - lam * (o[d0][r + 1] * rli[r + 1]);
                        o[d0][r] = a; o[d0][r + 1] = c; ssr[r] += a * a; ssr[r + 1] += c * c; } }
#pragma unroll
            for (int r = 0; r < 16; ++r) {
#pragma unroll
                for (int off = 1; off < 32; off <<= 1) ssr[r] += __shfl_xor(ssr[r], off);
                ssr[r] = __builtin_amdgcn_rsqf(ssr[r] * (1.0f / 128.0f) + EPS); }
            asm volatile("s_waitcnt lgkmcnt(0)" ::: "memory");
            bf16_t* stg = (bf16_t*)stash;
#pragma unroll
            for (int d0 = 0; d0 < 4; ++d0)
#pragma unroll
                for (int r = 0; r < 16; ++r) { const unsigned pk = pg8::cvt_pk_bf16(o[d0][r] * ssr[r], 0.f); stg[crow(r, ehi) * 128 + d0 * 32 + er32] = (bf16_t)(pk & 0xffffu); }
            asm volatile("s_waitcnt lgkmcnt(0)" ::: "memory");
            bf16_t* Ow = QO + (rowbase + q0 + wid * 32) * DM + h * 128;
#pragma unroll
            for (int i = 0; i < 8; ++i) { const int row = i * 4 + (elane >> 4), ch = elane & 15; const u32x4 v = *(const u32x4*)(stg + row * 128 + ch * 8); *(u32x4*)(Ow + (long)row * DM + ch * 8) = v; }
            asm volatile("s_waitcnt lgkmcnt(0)" ::: "memory");
        }
    }
}
#undef ATT_WAIT_BAR
#undef ATT_SB
#undef ATT_PIN
#undef ATT_MFMA
#undef ATT_PK
}

__device__ __forceinline__ float wave_sum(float v) {
#pragma unroll
    for (int o = 1; o < 64; o <<= 1) v += __shfl_xor(v, o);
    return v;
}
__device__ __forceinline__ void p0_transpose_item(const float* src, int ldn, int scol0, int k0, const float* ks, int kmask, float cs, bf16_t* dst, int drow0, int dld, int dk0, LAS float* scr, int lane) {
    f32x4 v[8]; float sc[8];
#pragma unroll
    for (int i = 0; i < 8; ++i) { const int kk = 8 * i + (lane >> 3); v[i] = *(const f32x4*)(src + (size_t)(k0 + kk) * ldn + scol0 + (lane & 7) * 4); sc[i] = ks ? ks[(k0 + kk) & kmask] * cs : cs; }
#pragma unroll
    for (int i = 0; i < 8; ++i) { const int kk = 8 * i + (lane >> 3); LAS float* d = scr + kk * 33 + (lane & 7) * 4; d[0] = v[i][0] * sc[i]; d[1] = v[i][1] * sc[i]; d[2] = v[i][2] * sc[i]; d[3] = v[i][3] * sc[i]; }
    asm volatile("s_waitcnt lgkmcnt(0)" ::: "memory");
    const int c = lane & 7;
#pragma unroll
    for (int j = 0; j < 4; ++j) { const int n = (lane >> 3) + 8 * j; const LAS float* s = scr + (8 * c) * 33 + n;
        u32x4 o; o.x = pg8::cvt_pk_bf16(s[0 * 33], s[1 * 33]); o.y = pg8::cvt_pk_bf16(s[2 * 33], s[3 * 33]); o.z = pg8::cvt_pk_bf16(s[4 * 33], s[5 * 33]); o.w = pg8::cvt_pk_bf16(s[6 * 33], s[7 * 33]);
        *(u32x4*)(dst + (size_t)(drow0 + n) * dld + dk0 + k0 + 8 * c) = o; }
    asm volatile("s_waitcnt lgkmcnt(0)" ::: "memory");
}
__device__ const double ROPE_F[32] = {
    0.15915494309189535, 0.11934937021124886, 0.08949940160889101, 0.06711508300522726, 0.050329212104487035, 0.03774158471741977, 0.0283021958306234, 0.02122365276477766,
    0.015915494309189534, 0.011934937021124886, 0.008949940160889102, 0.006711508300522725, 0.005032921210448704, 0.003774158471741977, 0.00283021958306234, 0.0021223652764777662,
    0.0015915494309189536, 0.0011934937021124885, 0.0008949940160889102, 0.0006711508300522726, 0.0005032921210448703, 0.00037741584717419774, 0.00028302195830623395, 0.0002122365276477766,
    0.00015915494309189535, 0.00011934937021124886, 8.949940160889102e-05, 6.711508300522725e-05, 5.0329212104487035e-05, 3.774158471741978e-05, 2.8302195830623396e-05, 2.122365276477766e-05};

#define XB_TMO      128
#define XB_XCNT(j)  (256  + 64 * (j))
#define XB_XSUB(j)  (1280 + 64 * (j))
#define XB_XGEN(j)  (2304 + 64 * (j))
#define XB_TOP      3328
#define XB_TOPGEN   3392
#define XCD_BAR_WORDS 3456
#define XB_SPIN_CAP (1u << 18)
__device__ __forceinline__ unsigned xb_ld(unsigned* p)              { return __hip_atomic_load(p, __ATOMIC_RELAXED, __HIP_MEMORY_SCOPE_AGENT); }
__device__ __forceinline__ unsigned xb_add(unsigned* p, unsigned v) { return __hip_atomic_fetch_add(p, v, __ATOMIC_RELAXED, __HIP_MEMORY_SCOPE_AGENT); }
__device__ __forceinline__ unsigned xb_xcc_id() { return (unsigned)__builtin_amdgcn_s_getreg((3 << 11) | 20) & 0xFu; }
#define XB_SPIN(cond, bar) do { unsigned _sp = 0; while (cond) { __builtin_amdgcn_s_sleep(1); \
    if ((++_sp & 255u) == 0u) { if (xb_ld(&(bar)[XB_TMO])) break; if (_sp > XB_SPIN_CAP) { atomicAdd(&(bar)[XB_TMO], 1u); break; } } } } while (0)
struct XcdBarrier { unsigned* bar; unsigned x; volatile LAS unsigned* st; };
__device__ __forceinline__ XcdBarrier xcd_barrier_post(unsigned* bar, volatile LAS unsigned* st) {
    XcdBarrier b; b.bar = bar; b.x = xb_xcc_id(); b.st = st;
    if (threadIdx.x == 0) (void)xb_add(&bar[XB_XCNT(b.x)], 1u);
    return b;
}
__device__ __forceinline__ void xcd_barrier_complete(unsigned* bar, unsigned x, unsigned& nloc, unsigned& nx) {
    const unsigned G = gridDim.x * gridDim.y * gridDim.z;
    unsigned sum, cnt, mine, sp = 0u;
    for (;;) {
        sum = 0u; cnt = 0u; mine = 0u;
#pragma unroll
        for (unsigned j = 0; j < 16; ++j) { const unsigned c = xb_ld(&bar[XB_XCNT(j)]); sum += c; cnt += (c > 0u) ? 1u : 0u; mine = (j == x) ? c : mine; }
        if (sum == G) break;
        __builtin_amdgcn_s_sleep(1);
        if ((++sp & 255u) == 0u) { if (xb_ld(&bar[XB_TMO])) break; if (sp > XB_SPIN_CAP) { atomicAdd(&bar[XB_TMO], 1u); break; } }
    }
    nloc = mine > 0u ? mine : 1u; nx = cnt > 0u ? cnt : 1u;
}
__device__ __forceinline__ void xcd_barrier(const XcdBarrier& b) {
    asm volatile("s_waitcnt vmcnt(0)" ::: "memory");
    __syncthreads();
    if (threadIdx.x == 0) {
        unsigned* bar = b.bar;
        __builtin_amdgcn_s_waitcnt(0);
        unsigned nloc = b.st[0], nx = b.st[1];
        if (nloc == 0u) { xcd_barrier_complete(bar, b.x, nloc, nx); b.st[0] = nloc; b.st[1] = nx; }
        const unsigned old = xb_add(&bar[XB_XSUB(b.x)], 1u);
        const unsigned gen = old / nloc;
        if (old + 1u == (gen + 1u) * nloc) {
            __builtin_amdgcn_fence(__ATOMIC_RELEASE, "agent");
            asm volatile("s_waitcnt vmcnt(0)" ::: "memory");
            const unsigned og = xb_add(&bar[XB_TOP], 1u);
            const unsigned tg = og / nx;
            if (og + 1u == (tg + 1u) * nx) xb_add(&bar[XB_TOPGEN], 1u);
            else XB_SPIN(xb_ld(&bar[XB_TOPGEN]) == tg, bar);
            __builtin_amdgcn_fence(__ATOMIC_ACQUIRE, "agent");
            xb_add(&bar[XB_XGEN(b.x)], 1u);
            asm volatile("s_waitcnt vmcnt(0)" ::: "memory");
        } else {
            XB_SPIN(xb_ld(&bar[XB_XGEN(b.x)]) == gen, bar);
            __builtin_amdgcn_fence(__ATOMIC_ACQUIRE, "agent");
            asm volatile("s_waitcnt vmcnt(0)" ::: "memory");
        }
    }
    __syncthreads();
}

__device__ __forceinline__ void xcd_split_arrive(unsigned* w, const XcdBarrier& b) {
    asm volatile("s_waitcnt vmcnt(0)" ::: "memory");
    __syncthreads();
    if (threadIdx.x == 0) {
        const unsigned nloc = b.st[0], nx = b.st[1];
        const unsigned old = xb_add(&w[XB_XSUB(b.x)], 1u);
        if (old + 1u == nloc) {
            __builtin_amdgcn_fence(__ATOMIC_RELEASE, "agent");
            asm volatile("s_waitcnt vmcnt(0)" ::: "memory");
            const unsigned og = xb_add(&w[XB_TOP], 1u);
            if (og + 1u == nx) xb_add(&w[XB_TOPGEN], 1u);
        }
    }
}
__device__ __forceinline__ void xcd_split_wait(unsigned* w, const XcdBarrier& b) {
    if (threadIdx.x == 0) {
        XB_SPIN(xb_ld(&w[XB_TOPGEN]) == 0u, b.bar);
        __builtin_amdgcn_fence(__ATOMIC_ACQUIRE, "agent");
        asm volatile("s_waitcnt vmcnt(0)" ::: "memory");
    }
    __syncthreads();
}

struct Args { const float* in[19]; float* out; unsigned char* ws; int ph_lo, ph_hi; };

__global__ void __launch_bounds__(512, 2) fwd_kernel(Args args) {
    extern __shared__ __attribute__((aligned(16))) unsigned char lds_raw[];
    LAS unsigned char* lds = (LAS unsigned char*)lds_raw;
    const int tid = threadIdx.x, lane = tid & 63, wave = __builtin_amdgcn_readfirstlane(tid >> 6);
    const int G = gridDim.x, bx = blockIdx.x;
    const int vcu = (G % 8 == 0) ? (bx % 8) * (G / 8) + bx / 8 : bx;
    unsigned char* ws = args.ws;
    const float* x_p = args.in[0]; const float* x_s = args.in[1]; const float* g_mix = args.in[2]; const float* w_in = args.in[3]; const float* g_q = args.in[4]; const float* g_k = args.in[5];
    const float* lam_q1 = args.in[6]; const float* lam_k1 = args.in[7]; const float* lam_q2 = args.in[8]; const float* lam_k2 = args.in[9]; const float* g_sub = args.in[10];
    const float* w_attn = args.in[11]; const float* w_four = args.in[12]; const float* w_gate = args.in[13]; const float* b_gate = args.in[14]; const float* w_out = args.in[15];
    const float* g_mlp = args.in[16]; const float* w_up = args.in[17]; const float* w_down = args.in[18];
    float* out = args.out;
    float* SSQ = (float*)(ws + WS_SSQ);
    bf16_t* WUP = (bf16_t*)(ws + WS_WUP); bf16_t* WDN = (bf16_t*)(ws + WS_WDN); bf16_t* XB = (bf16_t*)(ws + WS_XB); bf16_t* QO = (bf16_t*)(ws + WS_QO);
    bf16_t* KB = (bf16_t*)(ws + WS_K); bf16_t* VB = (bf16_t*)(ws + WS_V); bf16_t* FT = (bf16_t*)(ws + WS_FT); bf16_t* W1 = (bf16_t*)(ws + WS_W1); bf16_t* DFT = (bf16_t*)(ws + WS_DFT);
    bf16_t* WMIX = (bf16_t*)(ws + WS_WMIX); bf16_t* WOUT = (bf16_t*)(ws + WS_WOUT); float* ROPEC = (float*)(ws + WS_ROPE); float* ROPES = ROPEC + SEQ * 32; bf16_t* UB = (bf16_t*)(ws + WS_U);
    bf16_t* G0 = (bf16_t*)out;
    bf16_t* MIXED = KB; bf16_t* PQ = (bf16_t*)out + (size_t)M * DM; bf16_t* X1B = XB;
    float* XN = (float*)(ws + WS_SSQ + 256 * 1024);

    const int lo = args.ph_lo, hi = args.ph_hi;
#define IN(k) (lo <= (k) && (k) < hi)
    unsigned* BARW = (unsigned*)(ws + WS_CTL);
    volatile LAS unsigned* MISC = (volatile LAS unsigned*)(lds + LDS_BYTES - 64);
    if (tid < 16) MISC[tid] = 0u;
    __syncthreads();
    XcdBarrier xbar = xcd_barrier_post(BARW, MISC);
#if MK_N_LAUNCHES == 1
#define SEAM(k) do { if (IN(k) && IN((k) + 1)) xcd_barrier(xbar); } while (0)
#else
#define SEAM(k) do { } while (0)
#endif

    if (IN(0)) for (int rep_ = 0; rep_ < REP_P0; ++rep_) {
        LAS float* scr = (LAS float*)(lds + wave * 16384);
        LAS float* tab = (LAS float*)(lds + 8 * 16384);
        if (tid < 128) { tab[tid] = cospif((float)tid * (1.0f / 64.0f)); tab[128 + tid] = sinpif((float)tid * (1.0f / 64.0f)); }
        __syncthreads();
        const bool wrole = wave >= 4;
        const int gw = vcu * 4 + (wave & 3), NGW = G * 4;
        if (wrole) {
        constexpr int IA = 1024, IB = 512, IC = 1024, ID = 256, NEARLY = IA + IB + IC + ID;
        for (int it = gw; it < NEARLY; it += NGW) {
            int r = it;
            if (r < IA) { const int rb = r >> 4, kb = r & 15, pn = rb >> 3, bj = (rb >> 2) & 1, wc = rb & 3, base = (pn < 4) ? 0 : 1024;
                p0_transpose_item(w_in, 3584, base + 64 * (4 * (pn & 3) + wc) + 32 * bj, 64 * kb, g_mix, 1023, 1.f, W1, 32 * rb, DM, 0, scr, lane); continue; } r -= IA;
            if (r < IB) { const int rb = r >> 4, kb = r & 15; p0_transpose_item(w_in, 3584, 2048 + 32 * rb, 64 * kb, g_mix, 1023, 1.f, W1, 2048 + 32 * rb, DM, 0, scr, lane); continue; } r -= IB;
            if (r < IC) { const int rb = r >> 4, kb = r & 15, pl = rb >> 3, bj = (rb >> 2) & 1, wc = rb & 3;
                p0_transpose_item(w_gate, 2048, bj * 1024 + 128 * pl + 32 * wc, 64 * kb, g_mix, 1023, 1.f, W1, 3072 + 32 * rb, DM, 0, scr, lane); continue; } r -= IC;
            { const int rb = r >> 4, kb = r & 15; p0_transpose_item(w_in, 3584, 3072 + 32 * rb, 64 * kb, g_mix, 1023, 1.f, W1, 5120 + 32 * rb, DM, 0, scr, lane); }
        }
        const int gt = vcu * 256 + (tid & 255), NGT = G * 256;
        for (int it = gt; it < 2048 * 128; it += NGT) { const int r2 = it >> 7, s0 = (it & 127) * 8, parity = r2 >> 10, r = r2 & 1023; const bool special = (parity == 0 && r == 512);
            const int kk = special ? 1024 : 2 * (r & 511) + parity; const bool usecos = (r < 512) || special; float v[8];
#pragma unroll
            for (int e = 0; e < 8; ++e) { const float ang = (float)((kk * (s0 + e)) & 2047) * (1.0f / 1024.0f); v[e] = usecos ? cospif(ang) : sinpif(ang); }
            u32x4 o; o.x = pg8::cvt_pk_bf16(v[0], v[1]); o.y = pg8::cvt_pk_bf16(v[2], v[3]); o.z = pg8::cvt_pk_bf16(v[4], v[5]); o.w = pg8::cvt_pk_bf16(v[6], v[7]);
            *(u32x4*)(DFT + (size_t)r2 * 1024 + s0) = o; }
        for (int it = gt; it < SEQ * 32; it += NGT) { const int s = it >> 5, d = it & 31; double t = (double)s * ROPE_F[d]; t -= __builtin_floor(t); const float a = (float)(2.0 * t);
            ROPEC[it] = cospif(a); ROPES[it] = sinpif(a); }
        for (int it = gt; it < M; it += NGT) SSQ[it] = 0.f;
        } else
        {
            auto xrowp = [&](int m) -> const f32x4* { return (const f32x4*)((m < NB_PROMPT * SEQ) ? x_p + (size_t)m * DM : x_s + (size_t)(m - NB_PROMPT * SEQ) * DM) + lane; };
            f32x4 v[4], w[4], nv[4], nw[4];
            { const f32x4* a = xrowp(gw); const f32x4* b = xrowp(gw + NGW);
#pragma unroll
              for (int j = 0; j < 4; ++j) { nv[j] = a[64 * j]; nw[j] = b[64 * j]; } }
            for (int m = gw; m < M; m += 2 * NGW) {
                const int m2 = m + NGW, mn = m + 2 * NGW;
#pragma unroll
                for (int j = 0; j < 4; ++j) { v[j] = nv[j]; w[j] = nw[j]; }
                if (mn < M) { const f32x4* a = xrowp(mn); const f32x4* b = xrowp(mn + NGW);
#pragma unroll
                    for (int j = 0; j < 4; ++j) { nv[j] = a[64 * j]; nw[j] = b[64 * j]; } }
                float s0 = 0.f, s1 = 0.f;
#pragma unroll
                for (int j = 0; j < 4; ++j) { s0 += (v[j].x * v[j].x + v[j].y * v[j].y) + (v[j].z * v[j].z + v[j].w * v[j].w); s1 += (w[j].x * w[j].x + w[j].y * w[j].y) + (w[j].z * w[j].z + w[j].w * w[j].w); }
                const float n0 = sqrtf(wave_sum(s0) * (1.0f / DM) + EPS), n1 = sqrtf(wave_sum(s1) * (1.0f / DM) + EPS), r0 = 1.0f / n0, r1 = 1.0f / n1;
                if (lane == 0) { XN[m] = n0; XN[m2] = n1; }
                u32x2* o0 = (u32x2*)(XB + (size_t)m * DM) + lane; u32x2* o1 = (u32x2*)(XB + (size_t)m2 * DM) + lane;
#pragma unroll
                for (int j = 0; j < 4; ++j) { u32x2 a, b; a.x = pg8::cvt_pk_bf16(v[j].x * r0, v[j].y * r0); a.y = pg8::cvt_pk_bf16(v[j].z * r0, v[j].w * r0);
                    b.x = pg8::cvt_pk_bf16(w[j].x * r1, w[j].y * r1); b.y = pg8::cvt_pk_bf16(w[j].z * r1, w[j].w * r1); o0[64 * j] = a; o1[64 * j] = b; }
            }
        }
        __syncthreads();
    }
    SEAM(0);

    if (IN(1)) {
        for (int rep_ = 0; rep_ < REP_P1A; ++rep_)
        { pg8::Gemm g{XB, W1, DM, DM, DM, 0, 0, nullptr, 0, 128, 256, 1}; pg8::StaticOrder S; S.init(M / 256, N1 / 256, 1, G, bx);
          LAS float* cst = (LAS float*)(lds + RING_BYTES);
          for (int i = tid; i < 2240; i += 512) cst[i] = (i < 2048) ? b_gate[i] : (i < 2112) ? g_q[i - 2048] : (i < 2176) ? g_k[i - 2112] : (i < 2208) ? ROPEC[16 * 32 + i - 2176] : ROPES[16 * 32 + i - 2208];
          __syncthreads();
          pg8::EpiG1 E{QO, KB, VB, G0, ROPEC, ROPES, cst};
          pg8::gemm_phase<pg8::EpiG1, true, false>(lds, g, S, E); }
        xcd_split_arrive(BARW + 4096, xbar);
        for (int rep_ = 0; rep_ < REP_P1B; ++rep_)
        { pg8::Gemm g{W1 + (size_t)N1 * DM, XB, DM, DM, DM, 0, (size_t)SEQ * DM, nullptr, 0, 1024, 128, 1 << 30}; pg8::StaticOrder S; S.init(FW / 256, 8, NBATCH, G, bx);
          pg8::EpiFT E{FT};
          pg8::gemm_phase<pg8::EpiFT, true, false>(lds, g, S, E); }
        xcd_split_arrive(BARW + 8192, xbar);
    }

    if (IN(2)) {
        {
            LAS float* scr = (LAS float*)(lds + wave * 16384);
            LAS float* tab = (LAS float*)(lds + 8 * 16384);
            if (tid < 128) { tab[tid] = cospif((float)tid * (1.0f / 64.0f)); tab[128 + tid] = sinpif((float)tid * (1.0f / 64.0f)); }
            __syncthreads();
            const int gw8 = vcu * 8 + wave, NGW8 = G * 8;
            constexpr int IE = 512, IF = 512, IG = 2048, IH = 2048, NLATE = IE + IF + IG + IH;
            for (int it = gw8; it < NLATE; it += NGW8) {
                int r = it;
                if (r < IE) { const int rb = r >> 4, kb = r & 15; p0_transpose_item(w_attn, 1024, 32 * rb, 64 * kb, g_sub, 127, 1.0f - LAMBDA_INIT, WMIX, 32 * rb, 2048, 1024, scr, lane); continue; } r -= IE;
                if (r < IF) { const int rb = r >> 4, kb = r & 15; p0_transpose_item(w_out, 1024, 32 * rb, 64 * kb, nullptr, 0, 1.f, WOUT, 32 * rb, DM, 0, scr, lane); continue; } r -= IF;
                if (r < IG) { const int rb = r >> 4, kb = r & 15; p0_transpose_item(w_up, 4096, 32 * rb, 64 * kb, g_mlp, 1023, 1.f, WUP, 32 * rb, DM, 0, scr, lane); continue; } r -= IG;
                { const int rb = r >> 6, kb = r & 63; p0_transpose_item(w_down, 1024, 32 * rb, 64 * kb, nullptr, 0, 1.f, WDN, 32 * rb, FF, 0, scr, lane); }
            }
            for (int it = gw8; it < 1024; it += NGW8) {
                const int pq = it >> 9, gg = (it >> 7) & 3, cb = (it >> 5) & 3, nb = it & 31, r32 = lane & 31, hi = lane >> 5;
                const LAS float* T = tab + pq * 128; const int c = 32 * cb + r32;
                float bv[64];
#pragma unroll
                for (int t = 0; t < 64; ++t) bv[t] = w_four[(size_t)(gg * 128 + 2 * t + hi) * DM + 32 * nb + r32];
                f32x16 acc = f32x16{};
#pragma unroll
                for (int t = 0; t < 64; ++t) acc = __builtin_amdgcn_mfma_f32_32x32x2f32(T[(c * (2 * t + hi)) & 127], bv[t], acc, 0, 0, 0);
                const float sgn = pq ? -(1.0f / 512.0f) : (1.0f / 512.0f);
                bf16_t* orow = WMIX + (size_t)(32 * nb + r32) * 2048 + pq * 512 + gg * 128 + 32 * cb + 4 * hi;
#pragma unroll
                for (int q = 0; q < 4; ++q) { u32x2 w; w.x = pg8::cvt_pk_bf16(acc[4 * q] * sgn, acc[4 * q + 1] * sgn); w.y = pg8::cvt_pk_bf16(acc[4 * q + 2] * sgn, acc[4 * q + 3] * sgn); *(u32x2*)(orow + 8 * q) = w; }
            }
            __syncthreads();
        }
        xcd_split_wait(BARW + 4096, xbar);
        const float s1 = wave_sum(lam_q1[lane] * lam_k1[lane]), s2 = wave_sum(lam_q2[lane] * lam_k2[lane]);
        const float lam = __expf(s1) - __expf(s2) + LAMBDA_INIT;
        for (int i = 0; ; ++i) { const int L = i * G + vcu, NU = NBATCH * NH * (SEQ / 256); if (L >= NU) break;
            const int bh = L >> 3, qb = L & 7, Ln = L + G, nbh = Ln >> 3;
            att::attn_unit(bh >> 3, bh & 7, qb, i == 0, Ln < NU, nbh >> 3, nbh & 7, QO, KB, VB, lam, (char*)lds_raw); }
        __syncthreads();
        xcd_split_wait(BARW + 8192, xbar);
        for (int rep_ = 0; rep_ < REP_DFT; ++rep_)
        { pg8::Gemm g{DFT, FT, 1024, M, 1024, (size_t)1024 * 1024, 1024, nullptr, 0, 128, 256, NBATCH}; pg8::StaticOrder S; S.init(1024 / 256, FW / 256, 2 * NBATCH, G, (bx + G / 2) % G);
          pg8::EpiDft E{PQ};
          pg8::gemm_phase<pg8::EpiDft, true, false>(lds, g, S, E); }
    }
    SEAM(2);

    if (IN(3)) for (int rep_ = 0; rep_ < REP_P3; ++rep_) {
        pg8::Gemm g{PQ, WMIX, DM, 2048, 2048, 0, 0, QO, 16, 128, 256, 1}; pg8::StaticOrder S; S.init(M / 256, DM / 256, 1, G, bx);
        pg8::EpiMix E{G0, MIXED};
        pg8::gemm_phase<pg8::EpiMix, true, true>(lds, g, S, E);
    }
    SEAM(3);

    if (IN(4)) {
        pg8::Gemm g{MIXED, WOUT, 256, DM, DM, 0, 0, nullptr, 0, 128, 256, 1}; pg8::StaticOrder S; S.init(M / 256, DM / 256, 1, G, bx);
        pg8::EpiOut E{XN, X1B, SSQ};
        pg8::gemm_phase<pg8::EpiOut, true, false>(lds, g, S, E);
    }
    SEAM(4);

    if (IN(5)) for (int rep_ = 0; rep_ < REP_P5; ++rep_) {
        pg8::Gemm g{X1B, WUP, DM, DM, DM, 0, 0, nullptr, 0, 128, 256, 1}; pg8::StaticOrder S; S.init(M / 256, FF / 256, 1, G, bx);
        pg8::EpiUp E{SSQ, UB};
        pg8::gemm_phase<pg8::EpiUp, true, false>(lds, g, S, E);
    }
    SEAM(5);

    if (IN(6)) {
        pg8::Gemm g{UB, WDN, 256, FF, FF, 0, 0, nullptr, 0, 128, 256, 1}; pg8::StaticOrder S; S.init(M / 256, DM / 256, 1, G, bx);
        pg8::EpiDown E{out, X1B};
        pg8::gemm_phase<pg8::EpiDown, true, false>(lds, g, S, E);
    }
#undef IN
#undef SEAM
}

extern "C" void kernel_launch(void* const* d_in, const int* in_sizes, int n_in, void* d_out, int out_size, void* d_ws, size_t ws_size, hipStream_t stream) {
    static int grid = 0;
    if (grid == 0) {
        if (n_in != 19 || out_size != M * DM || ws_size < WS_END) { fprintf(stderr, "kernel_launch: unexpected shapes (n_in %d, out %d, ws %zu)\n", n_in, out_size, ws_size); grid = -1; return; }
        int dev = 0, cus = 0, per_cu = 0;
        if (hipGetDevice(&dev) != hipSuccess || hipDeviceGetAttribute(&cus, hipDeviceAttributeMultiprocessorCount, dev) != hipSuccess) { grid = -1; return; }
        if (hipFuncSetAttribute((const void*)fwd_kernel, hipFuncAttributeMaxDynamicSharedMemorySize, LDS_BYTES) != hipSuccess) { fprintf(stderr, "kernel_launch: hipFuncSetAttribute failed\n"); grid = -1; return; }
        if (hipOccupancyMaxActiveBlocksPerMultiprocessor(&per_cu, (const void*)fwd_kernel, 512, LDS_BYTES) != hipSuccess || per_cu < 1) { fprintf(stderr, "kernel_launch: occupancy query says %d\n", per_cu); per_cu = 1; }
        (void)hipGetLastError();
        grid = cus;
        if (grid % 8 != 0) grid -= grid % 8;
    }
    if (grid < 0) return;
    if (hipMemsetAsync((char*)d_ws + WS_CTL, 0, 65536, stream) != hipSuccess) { fprintf(stderr, "kernel_launch: memset of the barrier words failed\n"); return; }
    Args a{};
    for (int i = 0; i < 19; ++i) a.in[i] = (const float*)d_in[i];
    a.out = (float*)d_out; a.ws = (unsigned char*)d_ws;
#if MK_N_LAUNCHES == 1
    a.ph_lo = 0; a.ph_hi = 7;
    void* kargs[] = {&a};
    hipError_t e = hipLaunchCooperativeKernel((const void*)fwd_kernel, dim3(grid), dim3(512), kargs, LDS_BYTES, stream);
    if (e != hipSuccess) fprintf(stderr, "cooperative launch failed: %s (grid %d)\n", hipGetErrorString(e), grid);
#else
    for (int p = 0; p < 7; ++p) { a.ph_lo = p; a.ph_hi = p + 1; hipLaunchKernelGGL(fwd_kernel, dim3(grid), dim3(512), LDS_BYTES, stream, a); }
#endif
}
```

```cpp
#include <hip/hip_runtime.h>
#include <hip/hip_cooperative_groups.h>
#include <hip/hip_bf16.h>
#include <cstdio>
#include <cstdint>
namespace cg = cooperative_groups;

#ifndef MK_N_LAUNCHES
#define MK_N_LAUNCHES 1
#endif

#ifndef REP_P0
#define REP_P0 1
#endif
#ifndef REP_P1A
#define REP_P1A 1
#endif
#ifndef REP_P1B
#define REP_P1B 1
#endif
#ifndef REP_DFT
#define REP_DFT 1
#endif
#ifndef REP_P3
#define REP_P3 1
#endif
#ifndef REP_P5
#define REP_P5 1
#endif
#define LAS __attribute__((address_space(3)))
#define GAS __attribute__((address_space(1)))
typedef unsigned short bf16_t;
typedef short bf16x8 __attribute__((ext_vector_type(8)));
typedef float f32x4 __attribute__((ext_vector_type(4)));
typedef float f32x2 __attribute__((ext_vector_type(2)));
typedef float f32x16 __attribute__((ext_vector_type(16)));
typedef unsigned u32x4 __attribute__((ext_vector_type(4)));
typedef unsigned u32x2 __attribute__((ext_vector_type(2)));
typedef short s16x4 __attribute__((ext_vector_type(4)));
typedef __bf16 bf16x2_t __attribute__((ext_vector_type(2)));

constexpr int DM = 1024, SEQ = 2048, NBATCH = 24, NB_PROMPT = 16, M = NBATCH * SEQ;
constexpr int NH = 8, HD = 64, FF = 4096, FW = 512;
constexpr int N1 = 5120;
constexpr float EPS = 1e-6f;
constexpr float LAMBDA_INIT = 0.2f;
constexpr float C2 = 0.125f * 1.4426950408889634f;

constexpr size_t MiB = 1u << 20;
constexpr size_t WS_CTL = 0;
constexpr size_t WS_SSQ = 1 * MiB;
constexpr size_t WS_WUP = 2 * MiB, WS_WDN = 10 * MiB;
constexpr size_t WS_XB = 18 * MiB;
constexpr size_t WS_QO = 114 * MiB;
constexpr size_t WS_K = 210 * MiB;
constexpr size_t WS_V = 306 * MiB;
constexpr size_t WS_FT = 402 * MiB;
constexpr size_t WS_W1 = 450 * MiB;
constexpr size_t WS_DFT = 461 * MiB;
constexpr size_t WS_WMIX = 477 * MiB;
constexpr size_t WS_WOUT = 481 * MiB;
constexpr size_t WS_ROPE = 483 * MiB;
constexpr size_t WS_U = 114 * MiB;
constexpr size_t WS_WMIX2 = 498 * MiB;
constexpr size_t WS_END = 502 * MiB;

constexpr int RING_BYTES = 131072;
constexpr int LDS_BYTES = 147456;

namespace pg8 {
constexpr int BM = 256, BK = 64, HALF = 128, HTB = HALF * BK * 2, NXCD = 8, WGM = 8;
__host__ __device__ __forceinline__ int lds_byte(int r, int c) { const int st = (r >> 4) * 2 + (c >> 5), rr = r & 15, cc = c & 31, ob = rr * 64 + cc * 2; return st * 1024 + (ob ^ (((ob >> 9) & 1) << 5)); }
__host__ __device__ __forceinline__ void stage_rc(int b, int& R, int& C) { const int st = b / 1024, sb = b % 1024, swz = sb ^ (((sb >> 9) & 1) << 5); R = (st >> 1) * 16 + swz / 64; C = (st & 1) * 32 + (swz % 64) / 2; }
__host__ __device__ __forceinline__ int perm32(int rho) { const int n = rho >> 4, i = rho & 15; return 8 * (i >> 2) + 4 * n + (i & 3); }

struct Unit { int pm, pn, pb; };
struct Gemm { const bf16_t* A; const bf16_t* Bt; int lda, ldb, K; size_t bsA, bsB; const bf16_t* A2; int ksplit; int hB, tB, adiv; const bf16_t* Bt2 = nullptr; };

struct StaticOrder {
    int nM, nN, nwg, G, c;
    __device__ void init(int nM_, int nN_, int nB_, int G_, int c_) { nM = nM_; nN = nN_; nwg = nM_ * nN_ * nB_; G = G_; c = c_; }
    __device__ bool next(int i, Unit& u) const {
        const long L = (long)i * G + c; if (L >= nwg) return false;
        int wgid = (int)L; { const int q = nwg / NXCD, r = nwg % NXCD, xcd = wgid % NXCD, off = wgid / NXCD; wgid = (xcd < r ? xcd * (q + 1) : r * (q + 1) + (xcd - r) * q) + off; }
        const int per = nM * nN; u.pb = wgid / per; const int id = wgid % per;
        const int nig = WGM * nN, gid = id / nig, fm = gid * WGM, gsz = (nM - fm) < WGM ? (nM - fm) : WGM;
        u.pm = fm + ((id % nig) % gsz); u.pn = (id % nig) / gsz; return true;
    }
};

__device__ __forceinline__ unsigned cvt_pk_bf16(float lo, float hi) { f32x2 v = {lo, hi}; bf16x2_t b = __builtin_convertvector(v, bf16x2_t); return __builtin_bit_cast(unsigned, b); }
__device__ __forceinline__ u32x4 pack8(const f32x4 a, const f32x4 b) { u32x4 w; w.x = cvt_pk_bf16(a[0], a[1]); w.y = cvt_pk_bf16(a[2], a[3]); w.z = cvt_pk_bf16(b[0], b[1]); w.w = cvt_pk_bf16(b[2], b[3]); return w; }
__device__ __forceinline__ void unpack8(const u32x4 w, f32x4& a, f32x4& b) {
    a[0] = __uint_as_float(w.x << 16); a[1] = __uint_as_float(w.x & 0xffff0000u); a[2] = __uint_as_float(w.y << 16); a[3] = __uint_as_float(w.y & 0xffff0000u);
    b[0] = __uint_as_float(w.z << 16); b[1] = __uint_as_float(w.z & 0xffff0000u); b[2] = __uint_as_float(w.w << 16); b[3] = __uint_as_float(w.w & 0xffff0000u); }

__device__ __forceinline__ float quad_sum(float v) {
    auto a = __builtin_amdgcn_permlane16_swap(__float_as_uint(v), __float_as_uint(v), false, false); v = __uint_as_float(a[0]) + __uint_as_float(a[1]);
    auto b = __builtin_amdgcn_permlane32_swap(__float_as_uint(v), __float_as_uint(v), false, false); return __uint_as_float(b[0]) + __uint_as_float(b[1]); }
typedef f32x4 Acc[2][2][4][2];

template <class Epi, bool ALIGN_EPI, bool SPLITA>
__device__ __forceinline__ void gemm_phase(LAS unsigned char* lds, const Gemm g, const StaticOrder& S, const Epi& E) {
    int tid = threadIdx.x; asm volatile("" : "+v"(tid));
    const int wid = __builtin_amdgcn_readfirstlane(tid >> 6), lane = tid & 63, wr = wid >> 2, wc = wid & 3, fr = lane & 15, fq = lane >> 4;
    const int K = g.K, nt = K / BK;
    unsigned voffA[2], voffB[2];
#pragma unroll
    for (int i = 0; i < 2; ++i) { int R, C; stage_rc(tid * 16 + i * 8192, R, C); const int Rb = (R & ~31) + perm32(R & 31);
        voffA[i] = (unsigned)(R * g.lda + C) * 2u; voffB[i] = (unsigned)(Rb * g.ldb + C) * 2u; }
    const size_t kstep = (size_t)(BK * 2);
    const size_t hstepA = (size_t)HALF * g.lda * 2, hstepB = (size_t)g.hB * g.ldb * 2;
    const size_t tstepA = 2 * hstepA, tstepB = (size_t)g.tB * g.ldb * 2;
    [[maybe_unused]] unsigned voffAm[2] = {0u, 0u};
    if constexpr (SPLITA) {
#pragma unroll
        for (int i = 0; i < 2; ++i) { int R, C; stage_rc(tid * 16 + i * 8192, R, C); voffAm[i] = (unsigned)((HALF - 1 - R) * g.lda + C) * 2u; }
    }
    auto kofs = [&](int t) -> size_t { if constexpr (Epi::KBLK) return (size_t)(t >> 2) * (BM * BM * 2) + (size_t)(t & 3) * kstep; else return (size_t)t * kstep; };
    auto mirrored = [&](const Unit& u) -> bool { return SPLITA && (u.pm & 4) != 0; };
    auto baseA1 = [&](const Unit& u) -> const char* {
        if (SPLITA && (u.pm & 4)) return (const char*)g.A + ((size_t)(u.pm & ~7) * BM + (size_t)(2048 - BM * (u.pm & 7) - (HALF - 1))) * g.lda * 2;
        if constexpr (Epi::KBLK) return (const char*)g.A + (size_t)u.pm * ((size_t)BM * g.K * 2);
        return (const char*)g.A + (size_t)u.pm * tstepA + (size_t)(u.pb / g.adiv) * g.bsA * 2; };
    auto kofsB = [&](int t) -> size_t { if constexpr (Epi::KBLKB) return (size_t)(t >> 2) * (BM * BM * 2) + (size_t)(t & 3) * kstep; else return (size_t)t * kstep; };
    auto baseB = [&](const Unit& u) -> const char* {
        if constexpr (Epi::KBLKB) return (const char*)g.Bt + (size_t)u.pn * ((size_t)BM * g.K * 2);
        return (const char*)((SPLITA && (u.pm & 4)) ? g.Bt2 : g.Bt) + (size_t)u.pn * tstepB + (size_t)u.pb * g.bsB * 2; };
    const unsigned ldsw = (unsigned)wid * 1024u;
    const int aoff = lds_byte(wr * 64 + fr, fq * 8), boff = lds_byte(wc * 32 + fr, fq * 8);
#define PG8_SA(b, h) (((b) * 2 + (h)) * HTB)
#define PG8_SB(b, h) ((4 + (b) * 2 + (h)) * HTB)
#define PG8_STAGE(bufoff, gbase, voff) do { _Pragma("unroll") for (int _i = 0; _i < 2; ++_i) \
        __builtin_amdgcn_global_load_lds((const unsigned*)((const char*)(gbase) + (voff)[_i]), (LAS unsigned*)(lds + (bufoff) + ldsw + _i * 8192), 16, 0, 0); } while (0)
#define PG8_LDA(dst, b, h) do { _Pragma("unroll") for (int m = 0; m < 4; ++m) _Pragma("unroll") for (int k = 0; k < 2; ++k) dst[m][k] = *(const LAS bf16x8*)(lds + PG8_SA(b, h) + aoff + m * 2048 + k * 1024); } while (0)
#define PG8_LDB(dst, b, h) do { _Pragma("unroll") for (int n = 0; n < 2; ++n) _Pragma("unroll") for (int k = 0; k < 2; ++k) dst[n][k] = *(const LAS bf16x8*)(lds + PG8_SB(b, h) + boff + n * 2048 + k * 1024); } while (0)
#define PG8_MMA(ai, bj, At, Bt) do { __builtin_amdgcn_s_setprio(1); _Pragma("unroll") for (int m = 0; m < 4; ++m) _Pragma("unroll") for (int n = 0; n < 2; ++n) _Pragma("unroll") for (int k = 0; k < 2; ++k) \
        acc[ai][bj][m][n] = __builtin_amdgcn_mfma_f32_16x16x32_bf16(Bt[n][k], At[m][k], acc[ai][bj][m][n], 0, 0, 0); __builtin_amdgcn_s_setprio(0); } while (0)
#define PG8_WAIT_V(n) asm volatile("s_waitcnt vmcnt(" #n ")" ::: "memory")
#define PG8_WAIT_L(n) asm volatile("s_waitcnt lgkmcnt(" #n ")" ::: "memory")
#define PG8_BAR __builtin_amdgcn_s_barrier()
#define PG8_SCHED __builtin_amdgcn_sched_barrier(0)
    Unit cur, nxt; int ui = 0;
    if (!S.next(0, cur)) return;
    Acc acc;
#pragma unroll
    for (int a = 0; a < 2; ++a)
#pragma unroll
        for (int b = 0; b < 2; ++b)
#pragma unroll
            for (int m = 0; m < 4; ++m)
#pragma unroll
                for (int n = 0; n < 2; ++n) acc[a][b][m][n] = (f32x4){0.f, 0.f, 0.f, 0.f};
    bf16x8 At[4][2], B0[2][2], B1[2][2];
    const char* cA = baseA1(cur); const char* cB = baseB(cur);
    const char* cA2 = SPLITA ? (const char*)g.A2 + (size_t)cur.pm * tstepA : cA;
    bool mirC = mirrored(cur);
    { const unsigned vo[2] = {mirC ? voffAm[0] : voffA[0], mirC ? voffAm[1] : voffA[1]}; const char* cAh = mirC ? cA - hstepA : cA + hstepA;
      PG8_STAGE(PG8_SB(0, 0), cB, voffB); PG8_STAGE(PG8_SB(0, 1), cB + hstepB, voffB); PG8_STAGE(PG8_SA(0, 0), cA, vo); PG8_STAGE(PG8_SA(0, 1), cAh, vo);
      if (wr == 1) PG8_BAR;
      PG8_WAIT_V(2); PG8_BAR;
      PG8_STAGE(PG8_SB(1, 0), cB + kstep, voffB); PG8_STAGE(PG8_SA(1, 0), cA + kofs(1), vo); PG8_STAGE(PG8_SB(1, 1), cB + hstepB + kstep, voffB); }
    PG8_WAIT_V(6); PG8_BAR;
    for (;;) {
        const bool has_next = S.next(ui + 1, nxt);
        const char* nA = has_next ? baseA1(nxt) : cA;
        const char* nB = has_next ? baseB(nxt) : cB;
        const bool mirN = has_next ? mirrored(nxt) : mirC;
        for (int t = 0; t < nt; t += 2) {
            const bool last = (t == nt - 2);
            if constexpr (Epi::MIDK) { if (t == g.ksplit) E.mid(acc, cur, wr, wc, fr, fq); }
            const char *a1, *a2;
            if constexpr (SPLITA) {
                a1 = (t + 1 < g.ksplit) ? cA + (size_t)(t + 1) * kstep : cA2 + (size_t)(t + 1 - g.ksplit) * kstep;
                a2 = last ? nA : ((t + 2 < g.ksplit) ? cA + (size_t)(t + 2) * kstep : cA2 + (size_t)(t + 2 - g.ksplit) * kstep);
            } else { a1 = cA + kofs(t + 1); a2 = last ? nA : cA + kofs(t + 2); }
            const char* b2 = last ? nB : cB + kofsB(t + 2);
            const char* a3 = a2 + kstep; const char* b3 = b2 + kstep;
            const bool m1 = SPLITA && mirC && (t + 1 < g.ksplit), m2 = SPLITA && (last ? mirN : (mirC && (t + 2 < g.ksplit)));
            const unsigned vo1[2] = {m1 ? voffAm[0] : voffA[0], m1 ? voffAm[1] : voffA[1]}, vo2[2] = {m2 ? voffAm[0] : voffA[0], m2 ? voffAm[1] : voffA[1]};
            const char* a1h = m1 ? a1 - hstepA : a1 + hstepA; const char* a2h = m2 ? a2 - hstepA : a2 + hstepA;
            PG8_LDB(B0, 0, 0); PG8_LDB(B1, 0, 1); PG8_SCHED; PG8_LDA(At, 0, 0); PG8_STAGE(PG8_SA(1, 1), a1h, vo1);
            PG8_WAIT_V(8); PG8_WAIT_L(0); PG8_BAR; PG8_MMA(0, 0, At, B0); PG8_MMA(0, 1, At, B1); PG8_BAR; PG8_SCHED;
            PG8_LDA(At, 0, 1); PG8_STAGE(PG8_SB(0, 0), b2, voffB); PG8_STAGE(PG8_SB(0, 1), b2 + hstepB, voffB); PG8_STAGE(PG8_SA(0, 0), a2, vo2);
            PG8_WAIT_V(8); PG8_WAIT_L(0); PG8_BAR; PG8_MMA(1, 0, At, B0); PG8_MMA(1, 1, At, B1); PG8_BAR; PG8_SCHED;
            PG8_LDB(B0, 1, 0); PG8_LDB(B1, 1, 1); PG8_SCHED; PG8_LDA(At, 1, 0); PG8_STAGE(PG8_SA(0, 1), a2h, vo2);
            PG8_WAIT_V(8); PG8_WAIT_L(0); PG8_BAR; PG8_MMA(0, 0, At, B0); PG8_MMA(0, 1, At, B1); PG8_BAR; PG8_SCHED;
            PG8_LDA(At, 1, 1); PG8_STAGE(PG8_SB(1, 0), b3, voffB); PG8_STAGE(PG8_SB(1, 1), b3 + hstepB, voffB); PG8_STAGE(PG8_SA(1, 0), a3, vo2);
            PG8_WAIT_V(8); PG8_WAIT_L(0); PG8_BAR; PG8_MMA(1, 0, At, B0); PG8_MMA(1, 1, At, B1); PG8_BAR; PG8_SCHED;
        }
        if constexpr (ALIGN_EPI) { if (wr == 0) PG8_BAR; }
        E(acc, cur, wr, wc, fr, fq);
        if (!has_next) break;
#pragma unroll
        for (int a = 0; a < 2; ++a)
#pragma unroll
            for (int b = 0; b < 2; ++b)
#pragma unroll
                for (int m = 0; m < 4; ++m)
#pragma unroll
                    for (int n = 0; n < 2; ++n) acc[a][b][m][n] = (f32x4){0.f, 0.f, 0.f, 0.f};
        cur = nxt; cA = nA; cB = nB; mirC = mirN; if constexpr (SPLITA) cA2 = (const char*)g.A2 + (size_t)cur.pm * tstepA; ++ui;
        if constexpr (ALIGN_EPI) { if (wr == 1) PG8_BAR; }
    }
    PG8_WAIT_V(0);
    if constexpr (!ALIGN_EPI) { if (wr == 0) PG8_BAR; }
    PG8_BAR;
#undef PG8_SA
#undef PG8_SB
#undef PG8_STAGE
#undef PG8_LDA
#undef PG8_LDB
#undef PG8_MMA
#undef PG8_WAIT_V
#undef PG8_WAIT_L
#undef PG8_BAR
#undef PG8_SCHED
}

struct EpiFT {
    static constexpr bool KBLKB = false; static constexpr bool KBLK = false; static constexpr bool MIDK = false;
    bf16_t* O;
    __device__ __forceinline__ void mid(Acc&, const Unit&, int, int, int, int) const {}
    __device__ __forceinline__ void operator()(const Acc& acc, const Unit& u, int wr, int wc, int fr, int fq) const {
        const int row0 = u.pm * BM + wr * 64 + fr, col0 = u.pb * 1024 + u.pn * 128 + wc * 32 + 8 * fq;
#pragma unroll
        for (int ai = 0; ai < 2; ++ai)
#pragma unroll
            for (int m = 0; m < 4; ++m) { bf16_t* rowp = O + (size_t)(row0 + ai * HALF + m * 16) * M + col0;
                *(u32x4*)(rowp) = pack8(acc[ai][0][m][0] + acc[ai][1][m][0], acc[ai][0][m][1] + acc[ai][1][m][1]);
                *(u32x4*)(rowp + NBATCH * 1024) = pack8(acc[ai][0][m][0] - acc[ai][1][m][0], acc[ai][0][m][1] - acc[ai][1][m][1]); }
    }
};
struct EpiDft {
    static constexpr bool KBLKB = false; static constexpr bool KBLK = false; static constexpr bool MIDK = false;
    bf16_t* O;
    __device__ __forceinline__ void mid(Acc&, const Unit&, int, int, int, int) const {}
    __device__ __forceinline__ void operator()(const Acc& acc, const Unit& u, int wr, int wc, int fr, int fq) const {
        const int parity = u.pb / NBATCH, batch = u.pb - parity * NBATCH;
        const int r0 = u.pm * BM + wr * 64 + fr, col0 = u.pn * BM + wc * 32 + 8 * fq;
        bf16_t* base0 = O + (size_t)batch * SEQ * DM + col0;
#pragma unroll
        for (int ai = 0; ai < 2; ++ai)
#pragma unroll
            for (int m = 0; m < 4; ++m) { const int r = r0 + ai * HALF + m * 16, pq = r >> 9, k = 2 * (r & 511) + parity;
                bf16_t* base = base0 + pq * 512;
#pragma unroll
                for (int bj = 0; bj < 2; ++bj) { const u32x4 w = pack8(acc[ai][bj][m][0], acc[ai][bj][m][1]);
                    if (k != 0) { *(u32x4*)(base + (size_t)k * DM + bj * HALF) = w; }
                    else if (pq == 0) { *(u32x4*)(base + bj * HALF) = w; }
                    else { *(u32x4*)(base - 512 + (size_t)1024 * DM + bj * HALF) = w;
                           const u32x4 z = {0u, 0u, 0u, 0u}; *(u32x4*)(base + bj * HALF) = z; *(u32x4*)(base + (size_t)1024 * DM + bj * HALF) = z; } } }
    }
};
struct EpiG1 {
    static constexpr bool KBLKB = false; static constexpr bool KBLK = false; static constexpr bool MIDK = false;
    bf16_t *QO, *KB, *VB, *G0; const float *ropec, *ropes; const LAS float* cst;
    __device__ __forceinline__ void mid(Acc&, const Unit&, int, int, int, int) const {}
    __device__ __forceinline__ void operator()(const Acc& acc, const Unit& u, int wr, int wc, int fr, int fq) const {
        const int row0 = u.pm * BM + wr * 64 + fr; const int pn = u.pn;
        if (pn < 8) {
            const bool isq = pn < 4; const int hm = 4 * (pn & 3) + wc; bf16_t* dst = (isq ? QO : KB) + hm * 64 + 8 * fq; const LAS float* g = cst + 2048 + (isq ? 0 : 64) + 8 * fq;
            const float sc = isq ? C2 : 1.0f;
            const f32x4 gl0 = *(const LAS f32x4*)(g), gl1 = *(const LAS f32x4*)(g + 4), gh0 = *(const LAS f32x4*)(g + 32), gh1 = *(const LAS f32x4*)(g + 36);
            const f32x4 k0 = *(const LAS f32x4*)(cst + 2176 + 8 * fq), k1 = *(const LAS f32x4*)(cst + 2176 + 8 * fq + 4);
            const f32x4 t0 = *(const LAS f32x4*)(cst + 2208 + 8 * fq), t1 = *(const LAS f32x4*)(cst + 2208 + 8 * fq + 4);
#pragma unroll
            for (int ai = 0; ai < 2; ++ai) {
                const int sb = (row0 + ai * HALF) & (SEQ - 1);
                f32x4 c0 = *(const f32x4*)(ropec + sb * 32 + 8 * fq), c1 = *(const f32x4*)(ropec + sb * 32 + 8 * fq + 4);
                f32x4 s0 = *(const f32x4*)(ropes + sb * 32 + 8 * fq), s1 = *(const f32x4*)(ropes + sb * 32 + 8 * fq + 4);
#pragma unroll
                for (int m = 0; m < 4; ++m) {
                    const int row = row0 + ai * HALF + m * 16;
                    if (m > 0) { const f32x4 nc0 = c0 * k0 - s0 * t0, ns0 = s0 * k0 + c0 * t0, nc1 = c1 * k1 - s1 * t1, ns1 = s1 * k1 + c1 * t1; c0 = nc0; s0 = ns0; c1 = nc1; s1 = ns1; }
                    const f32x4 a0 = acc[ai][0][m][0], a1 = acc[ai][0][m][1], b0 = acc[ai][1][m][0], b1 = acc[ai][1][m][1];
                    f32x4 q2 = a0 * a0 + a1 * a1 + b0 * b0 + b1 * b1; float ss = (q2[0] + q2[1]) + (q2[2] + q2[3]);
                    ss = quad_sum(ss);
                    const float rinv = __builtin_amdgcn_rsqf(ss * (1.0f / 64.0f) + EPS) * sc;
                    const f32x4 y00 = a0 * rinv * gl0, y01 = a1 * rinv * gl1, y10 = b0 * rinv * gh0, y11 = b1 * rinv * gh1;
                    const f32x4 o00 = y00 * c0 - y10 * s0, o01 = y01 * c1 - y11 * s1, o10 = y10 * c0 + y00 * s0, o11 = y11 * c1 + y01 * s1;
                    bf16_t* rowp = dst + (size_t)row * DM;
                    *(u32x4*)(rowp) = pack8(o00, o01); *(u32x4*)(rowp + 32) = pack8(o10, o11);
                }
                asm volatile("" ::: "memory");
            }
        } else if (pn < 12) {
            const int col0 = (pn - 8) * BM + wc * 32 + 8 * fq;
#pragma unroll
            for (int ai = 0; ai < 2; ++ai)
#pragma unroll
                for (int m = 0; m < 4; ++m) { bf16_t* rowp = VB + (size_t)(row0 + ai * HALF + m * 16) * DM + col0;
#pragma unroll
                    for (int bj = 0; bj < 2; ++bj) *(u32x4*)(rowp + bj * HALF) = pack8(acc[ai][bj][m][0], acc[ai][bj][m][1]); }
        } else {
            const int col0 = (pn - 12) * 128 + wc * 32 + 8 * fq;
            const f32x4 ba0 = *(const LAS f32x4*)(cst + col0), ba1 = *(const LAS f32x4*)(cst + col0 + 4), bb0 = *(const LAS f32x4*)(cst + 1024 + col0), bb1 = *(const LAS f32x4*)(cst + 1024 + col0 + 4);
            const float NL2E = -1.4426950408889634f;
#pragma unroll
            for (int ai = 0; ai < 2; ++ai)
#pragma unroll
                for (int m = 0; m < 4; ++m) {
                    const int grow = row0 + ai * HALF + m * 16;
                    const size_t off = (size_t)(grow >> 8) * (BM * DM) + (size_t)(col0 >> 7) * (BM * 128) + (size_t)(grow & (BM - 1)) * 128 + (col0 & 127);
                    f32x4 z0[2] = {acc[ai][0][m][0] + ba0, acc[ai][0][m][1] + ba1}, z1[2] = {acc[ai][1][m][0] + bb0, acc[ai][1][m][1] + bb1};
                    u32x4 w = {0u, 0u, 0u, 0u}; const float C255 = 1.0f / 255.0f;
#pragma unroll
                    for (int n = 0; n < 2; ++n)
#pragma unroll
                        for (int e = 0; e < 4; ++e) {
                            const float e0 = __builtin_amdgcn_exp2f(fminf(z0[n][e] * NL2E, 40.f)), e1 = __builtin_amdgcn_exp2f(fminf(z1[n][e] * NL2E, 40.f));
                            const float q0 = fmaxf(__builtin_amdgcn_rcpf(__builtin_fmaf(e0, C255, C255)) + 0.5f, 1.0f), q1 = __builtin_amdgcn_rcpf(__builtin_fmaf(e1, C255, C255)) + 0.5f;
                            w[n] = __builtin_amdgcn_cvt_pk_u8_f32(q0, (unsigned)e, w[n]); w[2 + n] = __builtin_amdgcn_cvt_pk_u8_f32(q1, (unsigned)e, w[2 + n]); }
                    *(u32x4*)(G0 + off) = w;
                }
        }
    }
};
struct EpiMix {
    static constexpr bool KBLKB = false; static constexpr bool KBLK = false; static constexpr bool MIDK = true;
    const bf16_t* G0; bf16_t* O;
    template <int MODE> __device__ __forceinline__ void scale(Acc& acc, const Unit& u, int wr, int wc, int fr, int fq) const {
        int row0 = u.pm * BM + wr * 64 + fr; const int col0 = u.pn * BM + wc * 32 + 8 * fq;
        asm volatile("" : "+v"(row0));
        u32x4 gv[2][4][2];
#pragma unroll
        for (int ai = 0; ai < 2; ++ai)
#pragma unroll
            for (int m = 0; m < 4; ++m)
#pragma unroll
                for (int bj = 0; bj < 2; ++bj) { const int grow = row0 + ai * HALF + m * 16, gcol = col0 + bj * HALF;
                    const bf16_t* gp = G0 + (size_t)(grow >> 8) * (BM * DM) + (size_t)(gcol >> 7) * (BM * 128) + (size_t)(grow & (BM - 1)) * 128 + (gcol & 127);
                    if (MODE == 0) gv[ai][m][bj] = *(const u32x4*)gp;
                    else { const u32x2 h = *(const u32x2*)gp; gv[ai][m][bj] = (u32x4){h.x, h.y, 0u, 0u}; } }
        asm volatile("" ::: "memory");
#pragma unroll
        for (int ai = 0; ai < 2; ++ai)
#pragma unroll
            for (int m = 0; m < 4; ++m)
#pragma unroll
                for (int bj = 0; bj < 2; ++bj)
#pragma unroll
                    for (int n = 0; n < 2; ++n)
#pragma unroll
                        for (int e = 0; e < 4; ++e) { const float q0 = (float)((gv[ai][m][bj][n] >> (8 * e)) & 255u);
                            if (MODE == 0) { const float q1 = (float)((gv[ai][m][bj][2 + n] >> (8 * e)) & 255u); acc[ai][bj][m][n][e] *= q1 * __builtin_amdgcn_rcpf(q0); }
                            else acc[ai][bj][m][n][e] *= q0 * (1.0f / 255.0f); }
        asm volatile("" ::: "memory");
    }
    __device__ __forceinline__ void mid(Acc& acc, const Unit& u, int wr, int wc, int fr, int fq) const { scale<0>(acc, u, wr, wc, fr, fq); }
    __device__ __forceinline__ void operator()(Acc& acc, const Unit& u, int wr, int wc, int fr, int fq) const {
        scale<1>(acc, u, wr, wc, fr, fq);
        const int row0 = u.pm * BM + wr * 64 + fr, col0 = u.pn * BM + wc * 32 + 8 * fq;
#pragma unroll
        for (int ai = 0; ai < 2; ++ai)
#pragma unroll
            for (int m = 0; m < 4; ++m) { bf16_t* rowp = O + (size_t)u.pm * (BM * DM) + (size_t)u.pn * (BM * BM) + (size_t)((row0 + ai * HALF + m * 16) & (BM - 1)) * BM + (col0 & (BM - 1));
#pragma unroll
                for (int bj = 0; bj < 2; ++bj) *(u32x4*)(rowp + bj * HALF) = pack8(acc[ai][bj][m][0], acc[ai][bj][m][1]); }
    }
};
struct EpiOut {
    static constexpr bool KBLKB = false; static constexpr bool KBLK = true;  static constexpr bool MIDK = false;
    const float* xn; bf16_t* X1B; float* ssq;
    __device__ __forceinline__ void mid(Acc&, const Unit&, int, int, int, int) const {}
    __device__ __forceinline__ void operator()(const Acc& acc, const Unit& u, int wr, int wc, int fr, int fq) const {
        const int row0 = u.pm * BM + wr * 64 + fr, col0 = u.pn * BM + wc * 32 + 8 * fq;
#pragma unroll
        for (int ai = 0; ai < 2; ++ai) {
            u32x4 xw[4][2]; float nr[4];
#pragma unroll
            for (int m = 0; m < 4; ++m) { nr[m] = xn[row0 + ai * HALF + m * 16];
#pragma unroll
                for (int bj = 0; bj < 2; ++bj) xw[m][bj] = *(const u32x4*)(X1B + (size_t)(row0 + ai * HALF + m * 16) * DM + col0 + bj * HALF); }
#pragma unroll
            for (int m = 0; m < 4; ++m) {
                const int row = row0 + ai * HALF + m * 16; const size_t off = (size_t)row * DM + col0; float ss = 0.f;
#pragma unroll
                for (int bj = 0; bj < 2; ++bj) {
                    f32x4 xa, xb2; unpack8(xw[m][bj], xa, xb2);
                    const f32x4 v0 = xa * nr[m] + acc[ai][bj][m][0], v1 = xb2 * nr[m] + acc[ai][bj][m][1];
                    *(u32x4*)(X1B + off + bj * HALF) = pack8(v0, v1);
                    const f32x4 q = v0 * v0 + v1 * v1; ss += (q[0] + q[1]) + (q[2] + q[3]); }
                ss = quad_sum(ss);
                if (fq == 0) atomicAdd(ssq + row, ss);
            }
            asm volatile("" ::: "memory");
        }
    }
};
struct EpiUp {
    static constexpr bool KBLKB = false; static constexpr bool KBLK = false; static constexpr bool MIDK = false;
    const float* ssq; bf16_t* U;
    __device__ __forceinline__ void mid(Acc&, const Unit&, int, int, int, int) const {}
    __device__ __forceinline__ void operator()(const Acc& acc, const Unit& u, int wr, int wc, int fr, int fq) const {
        const int row0 = u.pm * BM + wr * 64 + fr, col0 = u.pn * BM + wc * 32 + 8 * fq;
#pragma unroll
        for (int ai = 0; ai < 2; ++ai)
#pragma unroll
            for (int m = 0; m < 4; ++m) {
                const int row = row0 + ai * HALF + m * 16; const float rinv = __builtin_amdgcn_rsqf(ssq[row] * (1.0f / DM) + EPS);
                bf16_t* rowp = U + (size_t)u.pm * (BM * FF) + (size_t)u.pn * (BM * BM) + (size_t)(row & (BM - 1)) * BM + (col0 & (BM - 1));
#pragma unroll
                for (int bj = 0; bj < 2; ++bj) { f32x4 v0 = acc[ai][bj][m][0] * rinv, v1 = acc[ai][bj][m][1] * rinv;
#pragma unroll
                    for (int e = 0; e < 4; ++e) { const float a = fmaxf(v0[e], 0.f), b = fmaxf(v1[e], 0.f); v0[e] = a * a; v1[e] = b * b; }
                    *(u32x4*)(rowp + bj * HALF) = pack8(v0, v1); }
            }
    }
};
struct EpiDown {
    static constexpr bool KBLKB = true; static constexpr bool KBLK = true; static constexpr bool MIDK = false;
    float* out; const bf16_t* X1B;
    __device__ __forceinline__ void mid(Acc&, const Unit&, int, int, int, int) const {}
    __device__ __forceinline__ void operator()(const Acc& acc, const Unit& u, int wr, int wc, int fr, int fq) const {
        const int row0 = u.pm * BM + wr * 64 + fr, col0 = u.pn * BM + wc * 32 + 8 * fq;
#pragma unroll
        for (int ai = 0; ai < 2; ++ai) {
            u32x4 xv[4][2];
#pragma unroll
            for (int m = 0; m < 4; ++m)
#pragma unroll
                for (int bj = 0; bj < 2; ++bj) xv[m][bj] = *(const u32x4*)(X1B + (size_t)(row0 + ai * HALF + m * 16) * DM + col0 + bj * HALF);
#pragma unroll
            for (int m = 0; m < 4; ++m)
#pragma unroll
                for (int bj = 0; bj < 2; ++bj) { float* rowp = out + (size_t)(row0 + ai * HALF + m * 16) * DM + col0 + bj * HALF; f32x4 a, b; unpack8(xv[m][bj], a, b);
                    *(f32x4*)(rowp) = a + acc[ai][bj][m][0]; *(f32x4*)(rowp + 4) = b + acc[ai][bj][m][1]; }
            asm volatile("" ::: "memory");
        }
    }
};
}

namespace att {
constexpr int KVBLK = 64, NT = SEQ / KVBLK, QB = 256;
constexpr int KSLOT = 8192, VSLOT = 16384, NSLOT = 3;
constexpr int LDS_K = 0, LDS_V = NSLOT * KSLOT, LDS_ST = LDS_V + NSLOT * VSLOT, LDS_WS = LDS_ST + 8 * 8192, LDS_END = LDS_WS + 8 * 256;
static_assert(LDS_END <= RING_BYTES + 12288, "attention LDS");
typedef LAS const char* lds_cptr;
typedef short v4i16_t __attribute__((ext_vector_type(4)));
__device__ __forceinline__ int crow(int r, int hi) { return (r & 3) + 8 * (r >> 2) + 4 * hi; }
__device__ __forceinline__ void glds16(const void* gsrc, unsigned lds_dst) { unsigned keep;
    asm volatile("s_mov_b32 %0, m0\n\ts_mov_b32 m0, %2\n\ts_nop 0\n\tglobal_load_lds_dwordx4 %1, off\n\ts_mov_b32 m0, %0" : "=&s"(keep) : "v"(gsrc), "s"(lds_dst) : "memory"); }
__device__ __forceinline__ s16x4 vtr(lds_cptr p) { return __builtin_bit_cast(s16x4, __builtin_amdgcn_ds_read_tr16_b64_v4i16((LAS v4i16_t*)p)); }
__device__ __forceinline__ void kload2(bf16x8* kf, lds_cptr kp, int j) { kf[2 * j] = *(const LAS bf16x8*)(kp + j * 2048); kf[2 * j + 1] = *(const LAS bf16x8*)(kp + j * 2048 + 512); }
#define ATT_WAIT_BAR(N) asm volatile("s_waitcnt vmcnt(" #N ") lgkmcnt(0)\n\ts_barrier" ::: "memory")
#define ATT_SB() __builtin_amdgcn_sched_barrier(0)
#define ATT_PIN(x) asm volatile("" : "+v"(x))
#define ATT_MFMA(a, b, c) __builtin_amdgcn_mfma_f32_32x32x16_bf16(a, b, c, 0, 0, 0)
#define ATT_PK(lo, hi) pg8::cvt_pk_bf16(lo, hi)

__device__ __forceinline__ void attn_unit(int b, int h, int qb, bool first, bool has_next, int nb, int nh, bf16_t* QO, const bf16_t* __restrict__ K, const bf16_t* __restrict__ V, float lam, char* shm) {
    int tid = threadIdx.x; asm volatile("" : "+v"(tid));
    const int lane = tid & 63, r32 = lane & 31, hi = lane >> 5; const int wid = __builtin_amdgcn_readfirstlane(tid >> 6);
    const long rowbase = (long)b * SEQ; const int q0 = qb * QB;
    const unsigned lds0 = (unsigned)(uintptr_t)shm;
    const long klane = (long)lane * DM + wid * 8;
    const long vlane = (long)(16 * (wid & 3) + (lane >> 2)) * DM + (wid >> 2) * 32 + (lane & 3) * 8;
    const bf16_t* vsrc0 = V + rowbase * DM + h * 128 + vlane;
    const unsigned vdst = lds0 + LDS_V + wid * 1024, kdst = lds0 + LDS_K + wid * 1024;
    const lds_cptr shm3 = (lds_cptr)shm;
    const lds_cptr vp0 = shm3 + LDS_V + ((lane >> 4) & 1) * 32 + (lane & 3) * 8 + (4 * hi + ((lane & 15) >> 2)) * 64;
    const lds_cptr kp0 = shm3 + LDS_K + hi * 1024 + r32 * 16;
    f32x16 o[4];
#pragma unroll 1
    for (int map = 0; map < 2; ++map) {
        const int hm = 2 * h + map;
        const bf16_t* ksrc = K + rowbase * DM + hm * 64 + klane;
        const bf16_t* Qw = QO + (rowbase + q0 + wid * 32) * DM + hm * 64;
        bf16x8 qr[4];
#pragma unroll
        for (int d0 = 0; d0 < 4; ++d0) qr[d0] = *reinterpret_cast<const bf16x8*>(&Qw[(long)r32 * DM + d0 * 16 + hi * 8]);
#define DMA_K(t, slot) glds16(ksrc + (long)(t) * KVBLK * DM, (unsigned)__builtin_amdgcn_readfirstlane(kdst + (slot) * KSLOT))
#define DMA_V(t, slot) do { glds16(vsrc0 + (long)(t) * KVBLK * DM, (unsigned)__builtin_amdgcn_readfirstlane(vdst + (slot) * VSLOT)); \
        glds16(vsrc0 + (long)(t) * KVBLK * DM + 64, (unsigned)__builtin_amdgcn_readfirstlane(vdst + (slot) * VSLOT + 8192)); } while (0)
        if (map == 0 && first) { DMA_K(0, 0); DMA_V(0, 0); DMA_K(1, 1); DMA_K(2, 2); }
        float l_reg = 0.f;
#pragma unroll
        for (int d0 = 0; d0 < 4; ++d0) o[d0] = f32x16{};
        f32x16 pA0, pA1, pB0, pB1; bf16x8 kf[8]; s16x4 vlo[4], vhi[4]; u32x4 pw0, pw1, pw2, pw3;
        int sl_prev = 0, sl_cur = 0, sl_next = 1;
#define ROT() do { sl_prev = sl_cur; sl_cur = sl_next; sl_next = (sl_next == 2) ? 0 : sl_next + 1; } while (0)
        ATT_WAIT_BAR(4);
        { const lds_cptr kp = kp0; pA0 = f32x16{}; pA1 = f32x16{};
#pragma unroll
          for (int d0 = 0; d0 < 4; ++d0) { const bf16x8 k0 = *(const LAS bf16x8*)(kp + d0 * 2048), k1 = *(const LAS bf16x8*)(kp + d0 * 2048 + 512);
              pA0 = ATT_MFMA(k0, qr[d0], pA0); pA1 = ATT_MFMA(k1, qr[d0], pA1); }
#pragma unroll
          for (int r = 0; r < 16; ++r) { pA0[r] = __builtin_amdgcn_exp2f(pA0[r]); pA1[r] = __builtin_amdgcn_exp2f(pA1[r]); }
          ATT_PIN(pA0); ATT_PIN(pA1); }
        ATT_SB();
        ATT_WAIT_BAR(0);
        DMA_K(3, 0); DMA_V(1, 1);
        ROT();
#pragma unroll
        for (int j = 0; j < 4; ++j) kload2(kf, kp0 + sl_cur * KSLOT, j);
        ATT_WAIT_BAR(3);
#define VOFF(j) ((((j) & 3) * 4096) + (((j) >> 2) * 1024))
#define VRD(j) do { vlo[(j) & 3] = vtr(vp_ + VOFF(j)); vhi[(j) & 3] = vtr(vp_ + VOFF(j) + 512); } while (0)
#define VFR(j) (bf16x8){vlo[(j) & 3][0], vlo[(j) & 3][1], vlo[(j) & 3][2], vlo[(j) & 3][3], vhi[(j) & 3][0], vhi[(j) & 3][1], vhi[(j) & 3][2], vhi[(j) & 3][3]}
#define PAF(k) __builtin_bit_cast(bf16x8, pw##k)
#define EX(v) __builtin_amdgcn_exp2f(v)
#define GAPA(MF, A0, A1, A2, A3, W0, W1, PW) do { MF; sacc += A0; sacc += A1; sacc += A2; sacc += A3; ATT_PIN(sacc); W0; W1; ATT_PIN(PW); ATT_SB(); } while (0)
#define GAPB(MF, X, B, RD) do { MF; X[B] = EX(X[B]); X[B + 1] = EX(X[B + 1]); ATT_PIN(X); RD; ATT_SB(); } while (0)
#define KRD(G, j) do { if (G) { kload2(kf, kp0 + sl_next * KSLOT, j); } } while (0)
#define NOP_ do { } while (0)
#define STEP(C0, C1, P0, P1, t, GK, GV, GL) do { ATT_SB(); \
        const lds_cptr vp_ = vp0 + sl_prev * VSLOT; \
        VRD(0); ATT_SB(); float sacc = (P0[0] + P0[1]); \
        GAPA(C0 = ATT_MFMA(kf[0], qr[0], (f32x16{})), P0[2], P0[3], P0[4], P0[5],     pw0[0] = ATT_PK(P0[0], P0[1]),   pw0[1] = ATT_PK(P0[2], P0[3]),   pw0); \
        VRD(1); ATT_SB(); GAPA(C1 = ATT_MFMA(kf[1], qr[0], (f32x16{})), P0[6], P0[7], P0[8], P0[9],     pw0[2] = ATT_PK(P0[4], P0[5]),   pw0[3] = ATT_PK(P0[6], P0[7]),   pw0); \
        VRD(2); ATT_SB(); GAPA(C0 = ATT_MFMA(kf[2], qr[1], C0),          P0[10], P0[11], P0[12], P0[13], pw1[0] = ATT_PK(P0[8], P0[9]),   pw1[1] = ATT_PK(P0[10], P0[11]), pw1); \
        VRD(3); ATT_SB(); GAPA(C1 = ATT_MFMA(kf[3], qr[1], C1),          P0[14], P0[15], P1[0], P1[1],   pw1[2] = ATT_PK(P0[12], P0[13]), pw1[3] = ATT_PK(P0[14], P0[15]), pw1); \
        GAPA(C0 = ATT_MFMA(kf[4], qr[2], C0),          P1[2], P1[3], P1[4], P1[5],     pw2[0] = ATT_PK(P1[0], P1[1]),   pw2[1] = ATT_PK(P1[2], P1[3]),   pw2); \
        GAPA(C1 = ATT_MFMA(kf[5], qr[2], C1),          P1[6], P1[7], P1[8], P1[9],     pw2[2] = ATT_PK(P1[4], P1[5]),   pw2[3] = ATT_PK(P1[6], P1[7]),   pw2); \
        GAPA(C0 = ATT_MFMA(kf[6], qr[3], C0),          P1[10], P1[11], P1[12], P1[13], pw3[0] = ATT_PK(P1[8], P1[9]),   pw3[1] = ATT_PK(P1[10], P1[11]), pw3); \
        GAPA(C1 = ATT_MFMA(kf[7], qr[3], C1),          P1[14], P1[15], 0.f, 0.f,       pw3[2] = ATT_PK(P1[12], P1[13]), pw3[3] = ATT_PK(P1[14], P1[15]), pw3); \
        l_reg += sacc; \
        if (GK) { DMA_K((t) + 3, sl_cur); } if (GV) { DMA_V((t) + 1, sl_next); } \
        ATT_SB(); \
        GAPB(o[0] = ATT_MFMA(PAF(0), VFR(0), o[0]),   C0, 0,  VRD(4)); \
        GAPB(o[1] = ATT_MFMA(PAF(0), VFR(1), o[1]),   C0, 2,  VRD(5)); \
        GAPB(o[2] = ATT_MFMA(PAF(0), VFR(2), o[2]),   C0, 4,  VRD(6)); \
        GAPB(o[3] = ATT_MFMA(PAF(0), VFR(3), o[3]),   C0, 6,  VRD(7)); \
        GAPB(o[0] = ATT_MFMA(PAF(1), VFR(4), o[0]),   C0, 8,  VRD(8)); \
        GAPB(o[1] = ATT_MFMA(PAF(1), VFR(5), o[1]),   C0, 10, VRD(9)); \
        KRD(GL, 0); GAPB(o[2] = ATT_MFMA(PAF(1), VFR(6), o[2]),   C0, 12, VRD(10)); \
        GAPB(o[3] = ATT_MFMA(PAF(1), VFR(7), o[3]),   C0, 14, VRD(11)); \
        KRD(GL, 1); GAPB(o[0] = ATT_MFMA(PAF(2), VFR(8), o[0]),   C1, 0,  VRD(12)); \
        GAPB(o[1] = ATT_MFMA(PAF(2), VFR(9), o[1]),   C1, 2,  VRD(13)); \
        KRD(GL, 2); GAPB(o[2] = ATT_MFMA(PAF(2), VFR(10), o[2]),  C1, 4,  VRD(14)); \
        GAPB(o[3] = ATT_MFMA(PAF(2), VFR(11), o[3]),  C1, 6,  VRD(15)); \
        KRD(GL, 3); GAPB(o[0] = ATT_MFMA(PAF(3), VFR(12), o[0]),  C1, 8,  NOP_); \
        GAPB(o[1] = ATT_MFMA(PAF(3), VFR(13), o[1]),  C1, 10, NOP_); \
        GAPB(o[2] = ATT_MFMA(PAF(3), VFR(14), o[2]),  C1, 12, NOP_); \
        GAPB(o[3] = ATT_MFMA(PAF(3), VFR(15), o[3]),  C1, 14, NOP_); \
        } while (0)
        int t = 1;
#pragma unroll 1
        for (; t + 1 <= NT - 4; t += 2) {
            STEP(pB0, pB1, pA0, pA1, t, true, true, true);     ATT_WAIT_BAR(3); ROT();
            STEP(pA0, pA1, pB0, pB1, t + 1, true, true, true); ATT_WAIT_BAR(3); ROT();
        }
        STEP(pB0, pB1, pA0, pA1, NT - 3, false, true, true);   ATT_WAIT_BAR(2); ROT();
        STEP(pA0, pA1, pB0, pB1, NT - 2, false, true, true);   ATT_WAIT_BAR(0); ROT();
        STEP(pB0, pB1, pA0, pA1, NT - 1, false, false, false);
        { float sacc = pB0[0] + pB0[1];
#pragma unroll
          for (int r = 2; r < 16; ++r) sacc += pB0[r];
#pragma unroll
          for (int r = 0; r < 16; ++r) sacc += pB1[r];
          l_reg += sacc;
          pw0 = (u32x4){ATT_PK(pB0[0], pB0[1]), ATT_PK(pB0[2], pB0[3]), ATT_PK(pB0[4], pB0[5]), ATT_PK(pB0[6], pB0[7])};
          pw1 = (u32x4){ATT_PK(pB0[8], pB0[9]), ATT_PK(pB0[10], pB0[11]), ATT_PK(pB0[12], pB0[13]), ATT_PK(pB0[14], pB0[15])};
          pw2 = (u32x4){ATT_PK(pB1[0], pB1[1]), ATT_PK(pB1[2], pB1[3]), ATT_PK(pB1[4], pB1[5]), ATT_PK(pB1[6], pB1[7])};
          pw3 = (u32x4){ATT_PK(pB1[8], pB1[9]), ATT_PK(pB1[10], pB1[11]), ATT_PK(pB1[12], pB1[13]), ATT_PK(pB1[14], pB1[15])};
          ATT_SB();
          const lds_cptr vp = vp0 + sl_cur * VSLOT;
#pragma unroll
          for (int d0 = 0; d0 < 4; ++d0) {
              const s16x4 l0 = vtr(vp + d0 * 4096), h0 = vtr(vp + d0 * 4096 + 512), l1 = vtr(vp + d0 * 4096 + 1024), h1 = vtr(vp + d0 * 4096 + 1536);
              const s16x4 l2 = vtr(vp + d0 * 4096 + 2048), h2 = vtr(vp + d0 * 4096 + 2560), l3 = vtr(vp + d0 * 4096 + 3072), h3 = vtr(vp + d0 * 4096 + 3584);
              o[d0] = ATT_MFMA(PAF(0), ((bf16x8){l0[0], l0[1], l0[2], l0[3], h0[0], h0[1], h0[2], h0[3]}), o[d0]);
              o[d0] = ATT_MFMA(PAF(1), ((bf16x8){l1[0], l1[1], l1[2], l1[3], h1[0], h1[1], h1[2], h1[3]}), o[d0]);
              o[d0] = ATT_MFMA(PAF(2), ((bf16x8){l2[0], l2[1], l2[2], l2[3], h2[0], h2[1], h2[2], h2[3]}), o[d0]);
              o[d0] = ATT_MFMA(PAF(3), ((bf16x8){l3[0], l3[1], l3[2], l3[3], h3[0], h3[1], h3[2], h3[3]}), o[d0]); } }
#undef STEP
#undef GAPA
#undef GAPB
#undef KRD
#undef NOP_
#undef VRD
#undef VFR
#undef VOFF
#undef PAF
#undef EX
#undef ROT
#undef DMA_K
#undef DMA_V
        ATT_SB();
        asm volatile("s_waitcnt lgkmcnt(0)\n\ts_barrier" ::: "memory");
        ATT_SB();
        if (map == 0 || has_next) {
            const bf16_t* nk = (map == 0) ? ksrc + 64 : K + (long)nb * SEQ * DM + (2 * nh) * 64 + klane;
            const bf16_t* nv = (map == 0) ? vsrc0 : V + (long)nb * SEQ * DM + nh * 128 + vlane;
            glds16(nk, (unsigned)__builtin_amdgcn_readfirstlane(kdst)); glds16(nv, (unsigned)__builtin_amdgcn_readfirstlane(vdst)); glds16(nv + 64, (unsigned)__builtin_amdgcn_readfirstlane(vdst + 8192));
            glds16(nk + (long)KVBLK * DM, (unsigned)__builtin_amdgcn_readfirstlane(kdst + KSLOT)); glds16(nk + 2L * KVBLK * DM, (unsigned)__builtin_amdgcn_readfirstlane(kdst + 2 * KSLOT)); }
        ATT_SB();
        { auto rr = __builtin_amdgcn_permlane32_swap(__float_as_uint(l_reg), __float_as_uint(l_reg), false, false); l_reg = __uint_as_float(rr[0]) + __uint_as_float(rr[1]); }
        int elane = lane; asm volatile("" : "+v"(elane));
        const int er32 = elane & 31, ehi = elane >> 5;
        float* wsf = (float*)(shm + LDS_WS) + wid * 64;
        u32x4* stash = (u32x4*)(shm + LDS_ST + wid * 8192);
        if (ehi == 0) wsf[er32] = l_reg;
        asm volatile("s_waitcnt lgkmcnt(0)" ::: "memory");
        float rli[16];
#pragma unroll
        for (int r = 0; r < 16; ++r) rli[r] = __builtin_amdgcn_rcpf(wsf[crow(r, ehi)]);
        asm volatile("s_waitcnt lgkmcnt(0)" ::: "memory");
        if (map == 0) {
#pragma unroll
            for (int d0 = 0; d0 < 4; ++d0)
#pragma unroll
                for (int i = 0; i < 2; ++i) { u32x4 w;
#pragma unroll
                    for (int j = 0; j < 4; ++j) { const int r = 8 * i + 2 * j; w[j] = pg8::cvt_pk_bf16(o[d0][r] * rli[r], o[d0][r + 1] * rli[r + 1]); }
                    stash[(d0 * 2 + i) * 64 + elane] = w; }
        } else {
            float ssr[16];
#pragma unroll
            for (int r = 0; r < 16; ++r) ssr[r] = 0.f;
#pragma unroll
            for (int d0 = 0; d0 < 4; ++d0)
#pragma unroll
                for (int i = 0; i < 2; ++i) { const u32x4 w = stash[(d0 * 2 + i) * 64 + elane];
#pragma unroll
                    for (int j = 0; j < 4; ++j) { const int r = 8 * i + 2 * j;
                        const float a = __uint_as_float(w[j] << 16) - lam * (o[d0][r] * rli[r]), c = __uint_as_float(w[j] & 0xffff0000u) - lam * (o[d0][r + 1] * rli[r + 1]);
                        o[d0][r] = a; o[d0][r + 1] = c; ssr[r] += a * a; ssr[r + 1] += c * c; } }
#pragma unroll
            for (int r = 0; r < 16; ++r) {
#pragma unroll
                for (int off = 1; off < 32; off <<= 1) ssr[r] += __shfl_xor(ssr[r], off);
                ssr[r] = __builtin_amdgcn_rsqf(ssr[r] * (1.0f / 128.0f) + EPS); }
            asm volatile("s_waitcnt lgkmcnt(0)" ::: "memory");
            bf16_t* stg = (bf16_t*)stash;
#pragma unroll
            for (int d0 = 0; d0 < 4; ++d0)
#pragma unroll
                for (int r = 0; r < 16; ++r) { const unsigned pk = pg8::cvt_pk_bf16(o[d0][r] * ssr[r], 0.f); stg[crow(r, ehi) * 128 + d0 * 32 + er32] = (bf16_t)(pk & 0xffffu); }
            asm volatile("s_waitcnt lgkmcnt(0)" ::: "memory");
            bf16_t* Ow = QO + (rowbase + q0 + wid * 32) * DM + h * 128;
#pragma unroll
            for (int i = 0; i < 8; ++i) { const int row = i * 4 + (elane >> 4), ch = elane & 15; const u32x4 v = *(const u32x4*)(stg + row * 128 + ch * 8); *(u32x4*)(Ow + (long)row * DM + ch * 8) = v; }
            asm volatile("s_waitcnt lgkmcnt(0)" ::: "memory");
        }
    }
}
#undef ATT_WAIT_BAR
#undef ATT_SB
#undef ATT_PIN
#undef ATT_MFMA
#undef ATT_PK
}

__device__ __forceinline__ float wave_sum(float v) {
#pragma unroll
    for (int o = 1; o < 64; o <<= 1) v += __shfl_xor(v, o);
    return v;
}
__device__ __forceinline__ void p0_transpose_item(const float* src, int ldn, int scol0, int k0, const float* ks, int kmask, float cs, bf16_t* dst, int drow0, int dld, int dk0, LAS float* scr, int lane) {
    f32x4 v[8]; float sc[8];
#pragma unroll
    for (int i = 0; i < 8; ++i) { const int kk = 8 * i + (lane >> 3); v[i] = *(const f32x4*)(src + (size_t)(k0 + kk) * ldn + scol0 + (lane & 7) * 4); sc[i] = ks ? ks[(k0 + kk) & kmask] * cs : cs; }
#pragma unroll
    for (int i = 0; i < 8; ++i) { const int kk = 8 * i + (lane >> 3); LAS float* d = scr + kk * 33 + (lane & 7) * 4; d[0] = v[i][0] * sc[i]; d[1] = v[i][1] * sc[i]; d[2] = v[i][2] * sc[i]; d[3] = v[i][3] * sc[i]; }
    asm volatile("s_waitcnt lgkmcnt(0)" ::: "memory");
    const int c = lane & 7;
#pragma unroll
    for (int j = 0; j < 4; ++j) { const int n = (lane >> 3) + 8 * j; const LAS float* s = scr + (8 * c) * 33 + n;
        u32x4 o; o.x = pg8::cvt_pk_bf16(s[0 * 33], s[1 * 33]); o.y = pg8::cvt_pk_bf16(s[2 * 33], s[3 * 33]); o.z = pg8::cvt_pk_bf16(s[4 * 33], s[5 * 33]); o.w = pg8::cvt_pk_bf16(s[6 * 33], s[7 * 33]);
        *(u32x4*)(dst + (size_t)(drow0 + n) * dld + dk0 + k0 + 8 * c) = o; }
    asm volatile("s_waitcnt lgkmcnt(0)" ::: "memory");
}
__device__ const double ROPE_F[32] = {
    0.15915494309189535, 0.11934937021124886, 0.08949940160889101, 0.06711508300522726, 0.050329212104487035, 0.03774158471741977, 0.0283021958306234, 0.02122365276477766,
    0.015915494309189534, 0.011934937021124886, 0.008949940160889102, 0.006711508300522725, 0.005032921210448704, 0.003774158471741977, 0.00283021958306234, 0.0021223652764777662,
    0.0015915494309189536, 0.0011934937021124885, 0.0008949940160889102, 0.0006711508300522726, 0.0005032921210448703, 0.00037741584717419774, 0.00028302195830623395, 0.0002122365276477766,
    0.00015915494309189535, 0.00011934937021124886, 8.949940160889102e-05, 6.711508300522725e-05, 5.0329212104487035e-05, 3.774158471741978e-05, 2.8302195830623396e-05, 2.122365276477766e-05};

#define XB_TMO      128
#define XB_XCNT(j)  (256  + 64 * (j))
#define XB_XSUB(j)  (1280 + 64 * (j))
#define XB_XGEN(j)  (2304 + 64 * (j))
#define XB_TOP      3328
#define XB_TOPGEN   3392
#define XCD_BAR_WORDS 3456
#define XB_SPIN_CAP (1u << 18)
__device__ __forceinline__ unsigned xb_ld(unsigned* p)              { return __hip_atomic_load(p, __ATOMIC_RELAXED, __HIP_MEMORY_SCOPE_AGENT); }
__device__ __forceinline__ unsigned xb_add(unsigned* p, unsigned v) { return __hip_atomic_fetch_add(p, v, __ATOMIC_RELAXED, __HIP_MEMORY_SCOPE_AGENT); }
__device__ __forceinline__ unsigned xb_xcc_id() { return (unsigned)__builtin_amdgcn_s_getreg((3 << 11) | 20) & 0xFu; }
#define XB_SPIN(cond, bar) do { unsigned _sp = 0; while (cond) { __builtin_amdgcn_s_sleep(1); \
    if ((++_sp & 255u) == 0u) { if (xb_ld(&(bar)[XB_TMO])) break; if (_sp > XB_SPIN_CAP) { atomicAdd(&(bar)[XB_TMO], 1u); break; } } } } while (0)
struct XcdBarrier { unsigned* bar; unsigned x; volatile LAS unsigned* st; };
__device__ __forceinline__ XcdBarrier xcd_barrier_post(unsigned* bar, volatile LAS unsigned* st) {
    XcdBarrier b; b.bar = bar; b.x = xb_xcc_id(); b.st = st;
    if (threadIdx.x == 0) (void)xb_add(&bar[XB_XCNT(b.x)], 1u);
    return b;
}
__device__ __forceinline__ void xcd_barrier_complete(unsigned* bar, unsigned x, unsigned& nloc, unsigned& nx) {
    const unsigned G = gridDim.x * gridDim.y * gridDim.z;
    unsigned sum, cnt, mine, sp = 0u;
    for (;;) {
        sum = 0u; cnt = 0u; mine = 0u;
#pragma unroll
        for (unsigned j = 0; j < 16; ++j) { const unsigned c = xb_ld(&bar[XB_XCNT(j)]); sum += c; cnt += (c > 0u) ? 1u : 0u; mine = (j == x) ? c : mine; }
        if (sum == G) break;
        __builtin_amdgcn_s_sleep(1);
        if ((++sp & 255u) == 0u) { if (xb_ld(&bar[XB_TMO])) break; if (sp > XB_SPIN_CAP) { atomicAdd(&bar[XB_TMO], 1u); break; } }
    }
    nloc = mine > 0u ? mine : 1u; nx = cnt > 0u ? cnt : 1u;
}
__device__ __forceinline__ void xcd_barrier(const XcdBarrier& b) {
    asm volatile("s_waitcnt vmcnt(0)" ::: "memory");
    __syncthreads();
    if (threadIdx.x == 0) {
        unsigned* bar = b.bar;
        __builtin_amdgcn_s_waitcnt(0);
        unsigned nloc = b.st[0], nx = b.st[1];
        if (nloc == 0u) { xcd_barrier_complete(bar, b.x, nloc, nx); b.st[0] = nloc; b.st[1] = nx; }
        const unsigned old = xb_add(&bar[XB_XSUB(b.x)], 1u);
        const unsigned gen = old / nloc;
        if (old + 1u == (gen + 1u) * nloc) {
            __builtin_amdgcn_fence(__ATOMIC_RELEASE, "agent");
            asm volatile("s_waitcnt vmcnt(0)" ::: "memory");
            const unsigned og = xb_add(&bar[XB_TOP], 1u);
            const unsigned tg = og / nx;
            if (og + 1u == (tg + 1u) * nx) xb_add(&bar[XB_TOPGEN], 1u);
            else XB_SPIN(xb_ld(&bar[XB_TOPGEN]) == tg, bar);
            __builtin_amdgcn_fence(__ATOMIC_ACQUIRE, "agent");
            xb_add(&bar[XB_XGEN(b.x)], 1u);
            asm volatile("s_waitcnt vmcnt(0)" ::: "memory");
        } else {
            XB_SPIN(xb_ld(&bar[XB_XGEN(b.x)]) == gen, bar);
            __builtin_amdgcn_fence(__ATOMIC_ACQUIRE, "agent");
            asm volatile("s_waitcnt vmcnt(0)" ::: "memory");
        }
    }
    __syncthreads();
}

__device__ __forceinline__ void xcd_split_arrive(unsigned* w, const XcdBarrier& b) {
    asm volatile("s_waitcnt vmcnt(0)" ::: "memory");
    __syncthreads();
    if (threadIdx.x == 0) {
        const unsigned nloc = b.st[0], nx = b.st[1];
        const unsigned old = xb_add(&w[XB_XSUB(b.x)], 1u);
        if (old + 1u == nloc) {
            __builtin_amdgcn_fence(__ATOMIC_RELEASE, "agent");
            asm volatile("s_waitcnt vmcnt(0)" ::: "memory");
            const unsigned og = xb_add(&w[XB_TOP], 1u);
            if (og + 1u == nx) xb_add(&w[XB_TOPGEN], 1u);
        }
    }
}
__device__ __forceinline__ void xcd_split_wait(unsigned* w, const XcdBarrier& b) {
    if (threadIdx.x == 0) {
        XB_SPIN(xb_ld(&w[XB_TOPGEN]) == 0u, b.bar);
        __builtin_amdgcn_fence(__ATOMIC_ACQUIRE, "agent");
        asm volatile("s_waitcnt vmcnt(0)" ::: "memory");
    }
    __syncthreads();
}

struct Args { const float* in[19]; float* out; unsigned char* ws; int ph_lo, ph_hi; };

__global__ void __launch_bounds__(512, 2) fwd_kernel(Args args) {
    extern __shared__ __attribute__((aligned(16))) unsigned char lds_raw[];
    LAS unsigned char* lds = (LAS unsigned char*)lds_raw;
    const int tid = threadIdx.x, lane = tid & 63, wave = __builtin_amdgcn_readfirstlane(tid >> 6);
    const int G = gridDim.x, bx = blockIdx.x;
    const int vcu = (G % 8 == 0) ? (bx % 8) * (G / 8) + bx / 8 : bx;
    unsigned char* ws = args.ws;
    const float* x_p = args.in[0]; const float* x_s = args.in[1]; const float* g_mix = args.in[2]; const float* w_in = args.in[3]; const float* g_q = args.in[4]; const float* g_k = args.in[5];
    const float* lam_q1 = args.in[6]; const float* lam_k1 = args.in[7]; const float* lam_q2 = args.in[8]; const float* lam_k2 = args.in[9]; const float* g_sub = args.in[10];
    const float* w_attn = args.in[11]; const float* w_four = args.in[12]; const float* w_gate = args.in[13]; const float* b_gate = args.in[14]; const float* w_out = args.in[15];
    const float* g_mlp = args.in[16]; const float* w_up = args.in[17]; const float* w_down = args.in[18];
    float* out = args.out;
    float* SSQ = (float*)(ws + WS_SSQ);
    bf16_t* WUP = (bf16_t*)(ws + WS_WUP); bf16_t* WDN = (bf16_t*)(ws + WS_WDN); bf16_t* XB = (bf16_t*)(ws + WS_XB); bf16_t* QO = (bf16_t*)(ws + WS_QO);
    bf16_t* KB = (bf16_t*)(ws + WS_K); bf16_t* VB = (bf16_t*)(ws + WS_V); bf16_t* FT = (bf16_t*)(ws + WS_FT); bf16_t* W1 = (bf16_t*)(ws + WS_W1); bf16_t* DFT = (bf16_t*)(ws + WS_DFT);
    bf16_t* WMIX = (bf16_t*)(ws + WS_WMIX); bf16_t* WMIX2 = (bf16_t*)(ws + WS_WMIX2); bf16_t* WOUT = (bf16_t*)(ws + WS_WOUT); float* ROPEC = (float*)(ws + WS_ROPE); float* ROPES = ROPEC + SEQ * 32; bf16_t* UB = (bf16_t*)(ws + WS_U);
    bf16_t* G0 = (bf16_t*)out;
    bf16_t* MIXED = KB; bf16_t* PQ = (bf16_t*)out + (size_t)M * DM; bf16_t* X1B = XB;
    float* XN = (float*)(ws + WS_SSQ + 256 * 1024);

    const int lo = args.ph_lo, hi = args.ph_hi;
#define IN(k) (lo <= (k) && (k) < hi)
    unsigned* BARW = (unsigned*)(ws + WS_CTL);
    volatile LAS unsigned* MISC = (volatile LAS unsigned*)(lds + LDS_BYTES - 64);
    if (tid < 16) MISC[tid] = 0u;
    __syncthreads();
    XcdBarrier xbar = xcd_barrier_post(BARW, MISC);
#if MK_N_LAUNCHES == 1
#define SEAM(k) do { if (IN(k) && IN((k) + 1)) xcd_barrier(xbar); } while (0)
#else
#define SEAM(k) do { } while (0)
#endif

    if (IN(0)) for (int rep_ = 0; rep_ < REP_P0; ++rep_) {
        LAS float* scr = (LAS float*)(lds + wave * 16384);
        LAS float* tab = (LAS float*)(lds + 8 * 16384);
        if (tid < 128) { tab[tid] = cospif((float)tid * (1.0f / 64.0f)); tab[128 + tid] = sinpif((float)tid * (1.0f / 64.0f)); }
        __syncthreads();
        const bool wrole = wave >= 4;
        const int gw = vcu * 4 + (wave & 3), NGW = G * 4;
        if (wrole) {
        constexpr int IA = 1024, IB = 512, IC = 1024, ID = 256, NEARLY = IA + IB + IC + ID;
        for (int it = gw; it < NEARLY; it += NGW) {
            int r = it;
            if (r < IA) { const int rb = r >> 4, kb = r & 15, pn = rb >> 3, bj = (rb >> 2) & 1, wc = rb & 3, base = (pn < 4) ? 0 : 1024;
                p0_transpose_item(w_in, 3584, base + 64 * (4 * (pn & 3) + wc) + 32 * bj, 64 * kb, g_mix, 1023, 1.f, W1, 32 * rb, DM, 0, scr, lane); continue; } r -= IA;
            if (r < IB) { const int rb = r >> 4, kb = r & 15; p0_transpose_item(w_in, 3584, 2048 + 32 * rb, 64 * kb, g_mix, 1023, 1.f, W1, 2048 + 32 * rb, DM, 0, scr, lane); continue; } r -= IB;
            if (r < IC) { const int rb = r >> 4, kb = r & 15, pl = rb >> 3, bj = (rb >> 2) & 1, wc = rb & 3;
                p0_transpose_item(w_gate, 2048, bj * 1024 + 128 * pl + 32 * wc, 64 * kb, g_mix, 1023, 1.f, W1, 3072 + 32 * rb, DM, 0, scr, lane); continue; } r -= IC;
            { const int rb = r >> 4, kb = r & 15; p0_transpose_item(w_in, 3584, 3072 + 32 * rb, 64 * kb, g_mix, 1023, 1.f, W1, 5120 + 32 * rb, DM, 0, scr, lane); }
        }
        const int gt = vcu * 256 + (tid & 255), NGT = G * 256;
        for (int it = gt; it < 2048 * 128; it += NGT) { const int r2 = it >> 7, s0 = (it & 127) * 8, parity = r2 >> 10, r = r2 & 1023; const bool special = (parity == 0 && r == 512);
            const int kk = special ? 1024 : 2 * (r & 511) + parity; const bool usecos = (r < 512) || special; float v[8];
#pragma unroll
            for (int e = 0; e < 8; ++e) { const float ang = (float)((kk * (s0 + e)) & 2047) * (1.0f / 1024.0f); v[e] = usecos ? cospif(ang) : sinpif(ang); }
            u32x4 o; o.x = pg8::cvt_pk_bf16(v[0], v[1]); o.y = pg8::cvt_pk_bf16(v[2], v[3]); o.z = pg8::cvt_pk_bf16(v[4], v[5]); o.w = pg8::cvt_pk_bf16(v[6], v[7]);
            *(u32x4*)(DFT + (size_t)r2 * 1024 + s0) = o; }
        for (int it = gt; it < SEQ * 32; it += NGT) { const int s = it >> 5, d = it & 31; double t = (double)s * ROPE_F[d]; t -= __builtin_floor(t); const float a = (float)(2.0 * t);
            ROPEC[it] = cospif(a); ROPES[it] = sinpif(a); }
        for (int it = gt; it < M; it += NGT) SSQ[it] = 0.f;
        } else
        {
            auto xrowp = [&](int m) -> const f32x4* { return (const f32x4*)((m < NB_PROMPT * SEQ) ? x_p + (size_t)m * DM : x_s + (size_t)(m - NB_PROMPT * SEQ) * DM) + lane; };
            f32x4 v[4], w[4], nv[4], nw[4];
            { const f32x4* a = xrowp(gw); const f32x4* b = xrowp(gw + NGW);
#pragma unroll
              for (int j = 0; j < 4; ++j) { nv[j] = a[64 * j]; nw[j] = b[64 * j]; } }
            for (int m = gw; m < M; m += 2 * NGW) {
                const int m2 = m + NGW, mn = m + 2 * NGW;
#pragma unroll
                for (int j = 0; j < 4; ++j) { v[j] = nv[j]; w[j] = nw[j]; }
                if (mn < M) { const f32x4* a = xrowp(mn); const f32x4* b = xrowp(mn + NGW);
#pragma unroll
                    for (int j = 0; j < 4; ++j) { nv[j] = a[64 * j]; nw[j] = b[64 * j]; } }
                float s0 = 0.f, s1 = 0.f;
#pragma unroll
                for (int j = 0; j < 4; ++j) { s0 += (v[j].x * v[j].x + v[j].y * v[j].y) + (v[j].z * v[j].z + v[j].w * v[j].w); s1 += (w[j].x * w[j].x + w[j].y * w[j].y) + (w[j].z * w[j].z + w[j].w * w[j].w); }
                const float n0 = sqrtf(wave_sum(s0) * (1.0f / DM) + EPS), n1 = sqrtf(wave_sum(s1) * (1.0f / DM) + EPS), r0 = 1.0f / n0, r1 = 1.0f / n1;
                if (lane == 0) { XN[m] = n0; XN[m2] = n1; }
                u32x2* o0 = (u32x2*)(XB + (size_t)m * DM) + lane; u32x2* o1 = (u32x2*)(XB + (size_t)m2 * DM) + lane;
#pragma unroll
                for (int j = 0; j < 4; ++j) { u32x2 a, b; a.x = pg8::cvt_pk_bf16(v[j].x * r0, v[j].y * r0); a.y = pg8::cvt_pk_bf16(v[j].z * r0, v[j].w * r0);
                    b.x = pg8::cvt_pk_bf16(w[j].x * r1, w[j].y * r1); b.y = pg8::cvt_pk_bf16(w[j].z * r1, w[j].w * r1); o0[64 * j] = a; o1[64 * j] = b; }
            }
        }
        __syncthreads();
    }
    SEAM(0);

    if (IN(1)) {
        for (int rep_ = 0; rep_ < REP_P1A; ++rep_)
        { pg8::Gemm g{XB, W1, DM, DM, DM, 0, 0, nullptr, 0, 128, 256, 1}; pg8::StaticOrder S; S.init(M / 256, N1 / 256, 1, G, bx);
          LAS float* cst = (LAS float*)(lds + RING_BYTES);
          for (int i = tid; i < 2240; i += 512) cst[i] = (i < 2048) ? b_gate[i] : (i < 2112) ? g_q[i - 2048] : (i < 2176) ? g_k[i - 2112] : (i < 2208) ? ROPEC[16 * 32 + i - 2176] : ROPES[16 * 32 + i - 2208];
          __syncthreads();
          pg8::EpiG1 E{QO, KB, VB, G0, ROPEC, ROPES, cst};
          pg8::gemm_phase<pg8::EpiG1, true, false>(lds, g, S, E); }
        xcd_split_arrive(BARW + 4096, xbar);
        for (int rep_ = 0; rep_ < REP_P1B; ++rep_)
        { pg8::Gemm g{W1 + (size_t)N1 * DM, XB, DM, DM, DM, 0, (size_t)SEQ * DM, nullptr, 0, 1024, 128, 1 << 30}; pg8::StaticOrder S; S.init(FW / 256, 8, NBATCH, G, bx);
          pg8::EpiFT E{FT};
          pg8::gemm_phase<pg8::EpiFT, true, false>(lds, g, S, E); }
        xcd_split_arrive(BARW + 8192, xbar);
    }

    if (IN(2)) {
        {
            LAS float* scr = (LAS float*)(lds + wave * 16384);
            LAS float* tab = (LAS float*)(lds + 8 * 16384);
            if (tid < 128) { tab[tid] = cospif((float)tid * (1.0f / 64.0f)); tab[128 + tid] = sinpif((float)tid * (1.0f / 64.0f)); }
            __syncthreads();
            const int gw8 = vcu * 8 + wave, NGW8 = G * 8;
            constexpr int IE = 512, IF = 512, IG = 2048, IH = 2048, NLATE = IE + IF + IG + IH;
            for (int it = gw8; it < NLATE; it += NGW8) {
                int r = it;
                if (r < IE) { const int rb = r >> 4, kb = r & 15; p0_transpose_item(w_attn, 1024, 32 * rb, 64 * kb, g_sub, 127, 1.0f - LAMBDA_INIT, WMIX, 32 * rb, 2048, 1024, scr, lane);
                              p0_transpose_item(w_attn, 1024, 32 * rb, 64 * kb, g_sub, 127, 1.0f - LAMBDA_INIT, WMIX2, 32 * rb, 2048, 1024, scr, lane); continue; } r -= IE;
                if (r < IF) { const int rb = r >> 4, kb = r & 15; p0_transpose_item(w_out, 1024, 32 * rb, 64 * kb, nullptr, 0, 1.f, WOUT, 32 * rb, DM, 0, scr, lane); continue; } r -= IF;
                if (r < IG) { const int rb = r >> 4, kb = r & 15; p0_transpose_item(w_up, 4096, 32 * rb, 64 * kb, g_mlp, 1023, 1.f, WUP, 32 * rb, DM, 0, scr, lane); continue; } r -= IG;
                { const int rb = r >> 6, kb = r & 63, drow = 32 * rb, k0 = 64 * kb;
                  p0_transpose_item(w_down, 1024, drow, k0, nullptr, 0, 1.f, WDN + (size_t)(drow >> 8) * (256 * FF) + (size_t)(k0 >> 8) * (256 * 256), drow & 255, 256, (k0 & 255) - k0, scr, lane); }
            }
            for (int it = gw8; it < 1024; it += NGW8) {
                const int pq = it >> 9, gg = (it >> 7) & 3, cb = (it >> 5) & 3, nb = it & 31, r32 = lane & 31, hi = lane >> 5;
                const LAS float* T = tab + pq * 128; const int c = 32 * cb + r32;
                float bv[64];
#pragma unroll
                for (int t = 0; t < 64; ++t) bv[t] = w_four[(size_t)(gg * 128 + 2 * t + hi) * DM + 32 * nb + r32];
                f32x16 acc = f32x16{};
#pragma unroll
                for (int t = 0; t < 64; ++t) acc = __builtin_amdgcn_mfma_f32_32x32x2f32(T[(c * (2 * t + hi)) & 127], bv[t], acc, 0, 0, 0);
                const float sgn = pq ? -(1.0f / 512.0f) : (1.0f / 512.0f);
                bf16_t* orow = WMIX + (size_t)(32 * nb + r32) * 2048 + pq * 512 + gg * 128 + 32 * cb + 4 * hi;
                bf16_t* orow2 = WMIX2 + (orow - WMIX); const unsigned flip = pq ? 0x80008000u : 0u;
#pragma unroll
                for (int q = 0; q < 4; ++q) { u32x2 w; w.x = pg8::cvt_pk_bf16(acc[4 * q] * sgn, acc[4 * q + 1] * sgn); w.y = pg8::cvt_pk_bf16(acc[4 * q + 2] * sgn, acc[4 * q + 3] * sgn); *(u32x2*)(orow + 8 * q) = w;
                    w.x ^= flip; w.y ^= flip; *(u32x2*)(orow2 + 8 * q) = w; }
            }
            __syncthreads();
        }
        xcd_split_wait(BARW + 4096, xbar);
        const float s1 = wave_sum(lam_q1[lane] * lam_k1[lane]), s2 = wave_sum(lam_q2[lane] * lam_k2[lane]);
        const float lam = __expf(s1) - __expf(s2) + LAMBDA_INIT;
        for (int i = 0; ; ++i) { const int L = i * G + vcu, NU = NBATCH * NH * (SEQ / 256); if (L >= NU) break;
            const int bh = L >> 3, qb = L & 7, Ln = L + G, nbh = Ln >> 3;
            att::attn_unit(bh >> 3, bh & 7, qb, i == 0, Ln < NU, nbh >> 3, nbh & 7, QO, KB, VB, lam, (char*)lds_raw); }
        __syncthreads();
        xcd_split_wait(BARW + 8192, xbar);
        for (int rep_ = 0; rep_ < REP_DFT; ++rep_)
        { pg8::Gemm g{DFT, FT, 1024, M, 1024, (size_t)1024 * 1024, 1024, nullptr, 0, 128, 256, NBATCH}; pg8::StaticOrder S; S.init(1024 / 256, FW / 256, 2 * NBATCH, G, (bx + G / 2) % G);
          pg8::EpiDft E{PQ};
          pg8::gemm_phase<pg8::EpiDft, true, false>(lds, g, S, E); }
    }
    SEAM(2);

    if (IN(3)) for (int rep_ = 0; rep_ < REP_P3; ++rep_) {
        pg8::Gemm g{PQ, WMIX, DM, 2048, 2048, 0, 0, QO, 16, 128, 256, 1, WMIX2}; pg8::StaticOrder S; S.init(M / 256, DM / 256, 1, G, bx);
        pg8::EpiMix E{G0, MIXED};
        pg8::gemm_phase<pg8::EpiMix, true, true>(lds, g, S, E);
    }
    SEAM(3);

    if (IN(4)) {
        pg8::Gemm g{MIXED, WOUT, 256, DM, DM, 0, 0, nullptr, 0, 128, 256, 1}; pg8::StaticOrder S; S.init(M / 256, DM / 256, 1, G, bx);
        pg8::EpiOut E{XN, X1B, SSQ};
        pg8::gemm_phase<pg8::EpiOut, true, false>(lds, g, S, E);
    }
    SEAM(4);

    if (IN(5)) for (int rep_ = 0; rep_ < REP_P5; ++rep_) {
        pg8::Gemm g{X1B, WUP, DM, DM, DM, 0, 0, nullptr, 0, 128, 256, 1}; pg8::StaticOrder S; S.init(M / 256, FF / 256, 1, G, bx);
        pg8::EpiUp E{SSQ, UB};
        pg8::gemm_phase<pg8::EpiUp, true, false>(lds, g, S, E);
    }
    SEAM(5);

    if (IN(6)) {
        pg8::Gemm g{UB, WDN, 256, 256, FF, 0, 0, nullptr, 0, 128, 256, 1}; pg8::StaticOrder S; S.init(M / 256, DM / 256, 1, G, bx);
        pg8::EpiDown E{out, X1B};
        pg8::gemm_phase<pg8::EpiDown, true, false>(lds, g, S, E);
    }
#undef IN
#undef SEAM
}

extern "C" void kernel_launch(void* const* d_in, const int* in_sizes, int n_in, void* d_out, int out_size, void* d_ws, size_t ws_size, hipStream_t stream) {
    static int grid = 0;
    if (grid == 0) {
        if (n_in != 19 || out_size != M * DM || ws_size < WS_END) { fprintf(stderr, "kernel_launch: unexpected shapes (n_in %d, out %d, ws %zu)\n", n_in, out_size, ws_size); grid = -1; return; }
        int dev = 0, cus = 0, per_cu = 0;
        if (hipGetDevice(&dev) != hipSuccess || hipDeviceGetAttribute(&cus, hipDeviceAttributeMultiprocessorCount, dev) != hipSuccess) { grid = -1; return; }
        if (hipFuncSetAttribute((const void*)fwd_kernel, hipFuncAttributeMaxDynamicSharedMemorySize, LDS_BYTES) != hipSuccess) { fprintf(stderr, "kernel_launch: hipFuncSetAttribute failed\n"); grid = -1; return; }
        if (hipOccupancyMaxActiveBlocksPerMultiprocessor(&per_cu, (const void*)fwd_kernel, 512, LDS_BYTES) != hipSuccess || per_cu < 1) { fprintf(stderr, "kernel_launch: occupancy query says %d\n", per_cu); per_cu = 1; }
        (void)hipGetLastError();
        grid = cus;
        if (grid % 8 != 0) grid -= grid % 8;
    }
    if (grid < 0) return;
    if (hipMemsetAsync((char*)d_ws + WS_CTL, 0, 65536, stream) != hipSuccess) { fprintf(stderr, "kernel_launch: memset of the barrier words failed\n"); return; }
    Args a{};
    for (int i = 0; i < 19; ++i) a.in[i] = (const float*)d_in[i];
    a.out = (float*)d_out; a.ws = (unsigned char*)d_ws;
#if MK_N_LAUNCHES == 1
    a.ph_lo = 0; a.ph_hi = 7;
    void* kargs[] = {&a};
    hipError_t e = hipLaunchCooperativeKernel((const void*)fwd_kernel, dim3(grid), dim3(512), kargs, LDS_BYTES, stream);
    if (e != hipSuccess) fprintf(stderr, "cooperative launch failed: %s (grid %d)\n", hipGetErrorString(e), grid);
#else
    for (int p = 0; p < 7; ++p) { a.ph_lo = p; a.ph_hi = p + 1; hipLaunchKernelGGL(fwd_kernel, dim3(grid), dim3(512), LDS_BYTES, stream, a); }
#endif
}
```

```cpp
#include <hip/hip_runtime.h>
#include <hip/hip_cooperative_groups.h>
#include <hip/hip_bf16.h>
#include <cstdio>
#include <cstdint>
namespace cg = cooperative_groups;

#ifndef MK_N_LAUNCHES
#define MK_N_LAUNCHES 1
#endif

#ifndef REP_P0
#define REP_P0 1
#endif
#ifndef REP_P1A
#define REP_P1A 1
#endif
#ifndef REP_P1B
#define REP_P1B 1
#endif
#ifndef REP_DFT
#define REP_DFT 1
#endif
#ifndef REP_P3
#define REP_P3 1
#endif
#ifndef REP_P5
#define REP_P5 1
#endif
#define LAS __attribute__((address_space(3)))
#define GAS __attribute__((address_space(1)))
typedef unsigned short bf16_t;
typedef short bf16x8 __attribute__((ext_vector_type(8)));
typedef float f32x4 __attribute__((ext_vector_type(4)));
typedef float f32x2 __attribute__((ext_vector_type(2)));
typedef float f32x16 __attribute__((ext_vector_type(16)));
typedef unsigned u32x4 __attribute__((ext_vector_type(4)));
typedef unsigned u32x2 __attribute__((ext_vector_type(2)));
typedef short s16x4 __attribute__((ext_vector_type(4)));
typedef __bf16 bf16x2_t __attribute__((ext_vector_type(2)));

constexpr int DM = 1024, SEQ = 2048, NBATCH = 24, NB_PROMPT = 16, M = NBATCH * SEQ;
constexpr int NH = 8, HD = 64, FF = 4096, FW = 512;
constexpr int N1 = 5120;
constexpr float EPS = 1e-6f;
constexpr float LAMBDA_INIT = 0.2f;
constexpr float C2 = 0.125f * 1.4426950408889634f;

constexpr size_t MiB = 1u << 20;
constexpr size_t WS_CTL = 0;
constexpr size_t WS_SSQ = 1 * MiB;
constexpr size_t WS_WUP = 2 * MiB, WS_WDN = 10 * MiB;
constexpr size_t WS_XB = 18 * MiB;
constexpr size_t WS_QO = 114 * MiB;
constexpr size_t WS_K = 210 * MiB;
constexpr size_t WS_V = 306 * MiB;
constexpr size_t WS_FT = 402 * MiB;
constexpr size_t WS_W1 = 450 * MiB;
constexpr size_t WS_DFT = 461 * MiB;
constexpr size_t WS_WMIX = 477 * MiB;
constexpr size_t WS_WOUT = 481 * MiB;
constexpr size_t WS_ROPE = 483 * MiB;
constexpr size_t WS_U = 114 * MiB;
constexpr size_t WS_WMIX2 = 498 * MiB;
constexpr size_t WS_END = 502 * MiB;

constexpr int RING_BYTES = 131072;
constexpr int LDS_BYTES = 147456;

namespace pg8 {
constexpr int BM = 256, BK = 64, HALF = 128, HTB = HALF * BK * 2, NXCD = 8, WGM = 8;
__host__ __device__ __forceinline__ int lds_byte(int r, int c) { const int st = (r >> 4) * 2 + (c >> 5), rr = r & 15, cc = c & 31, ob = rr * 64 + cc * 2; return st * 1024 + (ob ^ (((ob >> 9) & 1) << 5)); }
__host__ __device__ __forceinline__ void stage_rc(int b, int& R, int& C) { const int st = b / 1024, sb = b % 1024, swz = sb ^ (((sb >> 9) & 1) << 5); R = (st >> 1) * 16 + swz / 64; C = (st & 1) * 32 + (swz % 64) / 2; }
__host__ __device__ __forceinline__ int perm32(int rho) { const int n = rho >> 4, i = rho & 15; return 8 * (i >> 2) + 4 * n + (i & 3); }

struct Unit { int pm, pn, pb; };
struct Gemm { const bf16_t* A; const bf16_t* Bt; int lda, ldb, K; size_t bsA, bsB; const bf16_t* A2; int ksplit; int hB, tB, adiv; const bf16_t* Bt2 = nullptr; int bchunk = 0; };

struct StaticOrder {
    int nM, nN, nwg, G, c;
    __device__ void init(int nM_, int nN_, int nB_, int G_, int c_) { nM = nM_; nN = nN_; nwg = nM_ * nN_ * nB_; G = G_; c = c_; }
    __device__ bool next(int i, Unit& u) const {
        const long L = (long)i * G + c; if (L >= nwg) return false;
        int wgid = (int)L; { const int q = nwg / NXCD, r = nwg % NXCD, xcd = wgid % NXCD, off = wgid / NXCD; wgid = (xcd < r ? xcd * (q + 1) : r * (q + 1) + (xcd - r) * q) + off; }
        const int per = nM * nN; u.pb = wgid / per; const int id = wgid % per;
        const int nig = WGM * nN, gid = id / nig, fm = gid * WGM, gsz = (nM - fm) < WGM ? (nM - fm) : WGM;
        u.pm = fm + ((id % nig) % gsz); u.pn = (id % nig) / gsz; return true;
    }
};

__device__ __forceinline__ unsigned cvt_pk_bf16(float lo, float hi) { f32x2 v = {lo, hi}; bf16x2_t b = __builtin_convertvector(v, bf16x2_t); return __builtin_bit_cast(unsigned, b); }
__device__ __forceinline__ u32x4 pack8(const f32x4 a, const f32x4 b) { u32x4 w; w.x = cvt_pk_bf16(a[0], a[1]); w.y = cvt_pk_bf16(a[2], a[3]); w.z = cvt_pk_bf16(b[0], b[1]); w.w = cvt_pk_bf16(b[2], b[3]); return w; }
__device__ __forceinline__ void unpack8(const u32x4 w, f32x4& a, f32x4& b) {
    a[0] = __uint_as_float(w.x << 16); a[1] = __uint_as_float(w.x & 0xffff0000u); a[2] = __uint_as_float(w.y << 16); a[3] = __uint_as_float(w.y & 0xffff0000u);
    b[0] = __uint_as_float(w.z << 16); b[1] = __uint_as_float(w.z & 0xffff0000u); b[2] = __uint_as_float(w.w << 16); b[3] = __uint_as_float(w.w & 0xffff0000u); }

__device__ __forceinline__ float quad_sum(float v) {
    auto a = __builtin_amdgcn_permlane16_swap(__float_as_uint(v), __float_as_uint(v), false, false); v = __uint_as_float(a[0]) + __uint_as_float(a[1]);
    auto b = __builtin_amdgcn_permlane32_swap(__float_as_uint(v), __float_as_uint(v), false, false); return __uint_as_float(b[0]) + __uint_as_float(b[1]); }
typedef f32x4 Acc[2][2][4][2];

template <class Epi, bool ALIGN_EPI, bool SPLITA>
__device__ __forceinline__ void gemm_phase(LAS unsigned char* lds, const Gemm g, const StaticOrder& S, const Epi& E) {
    int tid = threadIdx.x; asm volatile("" : "+v"(tid));
    const int wid = __builtin_amdgcn_readfirstlane(tid >> 6), lane = tid & 63, wr = wid >> 2, wc = wid & 3, fr = lane & 15, fq = lane >> 4;
    const int K = g.K, nt = K / BK;
    unsigned voffA[2], voffB[2];
#pragma unroll
    for (int i = 0; i < 2; ++i) { int R, C; stage_rc(tid * 16 + i * 8192, R, C); const int Rb = (R & ~31) + perm32(R & 31);
        voffA[i] = Epi::KSUB ? (unsigned)((((R >> 4) * 8 + (C >> 5)) * 512) + (R & 15) * 32 + (C & 31)) * 2u : (unsigned)(R * g.lda + C) * 2u;
        voffB[i] = g.bchunk ? (unsigned)((((Rb >> 4) * (g.ldb >> 5) + (C >> 5)) * 512) + (Rb & 15) * 32 + (C & 31)) * 2u : (unsigned)(Rb * g.ldb + C) * 2u; }
    const size_t kstep = (size_t)(BK * 2);
    const size_t kstepB = g.bchunk ? (size_t)2048 : kstep;
    const size_t hstepA = (size_t)HALF * g.lda * 2, hstepB = (size_t)g.hB * g.ldb * 2;
    const size_t tstepA = 2 * hstepA, tstepB = (size_t)g.tB * g.ldb * 2;
    [[maybe_unused]] unsigned voffAm[2] = {0u, 0u}, voffA2[2] = {0u, 0u};
    if constexpr (SPLITA) {
#pragma unroll
        for (int i = 0; i < 2; ++i) { int R, C; stage_rc(tid * 16 + i * 8192, R, C); voffA2[i] = (unsigned)((((R >> 4) * (g.lda >> 5) + (C >> 5)) * 512) + (R & 15) * 32 + (C & 31)) * 2u; voffAm[i] = (unsigned)((HALF - 1 - R) * g.lda + C) * 2u; }
    }
    auto kofs = [&](int t) -> size_t { if constexpr (Epi::KBLK) return (size_t)(t >> 2) * (BM * BM * 2) + (size_t)(t & 3) * (Epi::KSUB ? (size_t)2048 : kstep); else return (size_t)t * kstep; };
    auto mirrored = [&](const Unit& u) -> bool { return SPLITA && (u.pm & 4) != 0; };
    auto baseA1 = [&](const Unit& u) -> const char* {
        if (SPLITA && (u.pm & 4)) return (const char*)g.A + ((size_t)(u.pm & ~7) * BM + (size_t)(2048 - BM * (u.pm & 7) - (HALF - 1))) * g.lda * 2;
        if constexpr (Epi::KBLK) return (const char*)g.A + (size_t)u.pm * ((size_t)BM * g.K * 2);
        return (const char*)g.A + (size_t)u.pm * tstepA + (size_t)(u.pb / g.adiv) * g.bsA * 2; };
    auto baseB = [&](const Unit& u) -> const char* { return (const char*)((SPLITA && (u.pm & 4)) ? g.Bt2 : g.Bt) + (size_t)u.pn * tstepB + (size_t)u.pb * g.bsB * 2; };
    const unsigned ldsw = (unsigned)wid * 1024u;
    const int aoff = lds_byte(wr * 64 + fr, fq * 8), boff = lds_byte(wc * 32 + fr, fq * 8);
#define PG8_SA(b, h) (((b) * 2 + (h)) * HTB)
#define PG8_SB(b, h) ((4 + (b) * 2 + (h)) * HTB)
#define PG8_STAGE(bufoff, gbase, voff) do { _Pragma("unroll") for (int _i = 0; _i < 2; ++_i) \
        __builtin_amdgcn_global_load_lds((const unsigned*)((const char*)(gbase) + (voff)[_i]), (LAS unsigned*)(lds + (bufoff) + ldsw + _i * 8192), 16, 0, 0); } while (0)
#define PG8_LDA(dst, b, h) do { _Pragma("unroll") for (int m = 0; m < 4; ++m) _Pragma("unroll") for (int k = 0; k < 2; ++k) dst[m][k] = *(const LAS bf16x8*)(lds + PG8_SA(b, h) + aoff + m * 2048 + k * 1024); } while (0)
#define PG8_LDB(dst, b, h) do { _Pragma("unroll") for (int n = 0; n < 2; ++n) _Pragma("unroll") for (int k = 0; k < 2; ++k) dst[n][k] = *(const LAS bf16x8*)(lds + PG8_SB(b, h) + boff + n * 2048 + k * 1024); } while (0)
#define PG8_MMA(ai, bj, At, Bt) do { __builtin_amdgcn_s_setprio(1); _Pragma("unroll") for (int m = 0; m < 4; ++m) _Pragma("unroll") for (int n = 0; n < 2; ++n) _Pragma("unroll") for (int k = 0; k < 2; ++k) \
        acc[ai][bj][m][n] = __builtin_amdgcn_mfma_f32_16x16x32_bf16(Bt[n][k], At[m][k], acc[ai][bj][m][n], 0, 0, 0); __builtin_amdgcn_s_setprio(0); } while (0)
#define PG8_WAIT_V(n) asm volatile("s_waitcnt vmcnt(" #n ")" ::: "memory")
#define PG8_WAIT_L(n) asm volatile("s_waitcnt lgkmcnt(" #n ")" ::: "memory")
#define PG8_BAR __builtin_amdgcn_s_barrier()
#define PG8_SCHED __builtin_amdgcn_sched_barrier(0)
    Unit cur, nxt; int ui = 0;
    if (!S.next(0, cur)) return;
    Acc acc;
#pragma unroll
    for (int a = 0; a < 2; ++a)
#pragma unroll
        for (int b = 0; b < 2; ++b)
#pragma unroll
            for (int m = 0; m < 4; ++m)
#pragma unroll
                for (int n = 0; n < 2; ++n) acc[a][b][m][n] = (f32x4){0.f, 0.f, 0.f, 0.f};
    bf16x8 At[4][2], B0[2][2], B1[2][2];
    const char* cA = baseA1(cur); const char* cB = baseB(cur);
    const char* cA2 = SPLITA ? (const char*)g.A2 + (size_t)cur.pm * tstepA : cA;
    bool mirC = mirrored(cur);
    { const unsigned vo[2] = {mirC ? voffAm[0] : voffA[0], mirC ? voffAm[1] : voffA[1]}; const char* cAh = mirC ? cA - hstepA : cA + hstepA;
      PG8_STAGE(PG8_SB(0, 0), cB, voffB); PG8_STAGE(PG8_SB(0, 1), cB + hstepB, voffB); PG8_STAGE(PG8_SA(0, 0), cA, vo); PG8_STAGE(PG8_SA(0, 1), cAh, vo);
      if (wr == 1) PG8_BAR;
      PG8_WAIT_V(2); PG8_BAR;
      PG8_STAGE(PG8_SB(1, 0), cB + kstepB, voffB); PG8_STAGE(PG8_SA(1, 0), cA + kofs(1), vo); PG8_STAGE(PG8_SB(1, 1), cB + hstepB + kstepB, voffB); }
    PG8_WAIT_V(6); PG8_BAR;
    for (;;) {
        const bool has_next = S.next(ui + 1, nxt);
        const char* nA = has_next ? baseA1(nxt) : cA;
        const char* nB = has_next ? baseB(nxt) : cB;
        const bool mirN = has_next ? mirrored(nxt) : mirC;
        for (int t = 0; t < nt; t += 2) {
            const bool last = (t == nt - 2);
            if constexpr (Epi::MIDK) { if (t == g.ksplit) E.mid(acc, cur, wr, wc, fr, fq); }
            const char *a1, *a2;
            if constexpr (SPLITA) {
                a1 = (t + 1 < g.ksplit) ? cA + (size_t)(t + 1) * kstep : cA2 + (size_t)(t + 1 - g.ksplit) * 2048;
                a2 = last ? nA : ((t + 2 < g.ksplit) ? cA + (size_t)(t + 2) * kstep : cA2 + (size_t)(t + 2 - g.ksplit) * 2048);
            } else { a1 = cA + kofs(t + 1); a2 = last ? nA : cA + kofs(t + 2); }
            const char* b2 = last ? nB : cB + (size_t)(t + 2) * kstepB;
            const bool s2a = SPLITA && (t + 1 >= g.ksplit), s2b = SPLITA && !last && (t + 2 >= g.ksplit);
            const char* a3 = a2 + ((Epi::KSUB || s2b) ? (size_t)2048 : kstep); const char* b3 = b2 + kstepB;
            const bool m1 = SPLITA && mirC && (t + 1 < g.ksplit), m2 = SPLITA && (last ? mirN : (mirC && (t + 2 < g.ksplit)));
            const unsigned vo1[2] = {s2a ? voffA2[0] : m1 ? voffAm[0] : voffA[0], s2a ? voffA2[1] : m1 ? voffAm[1] : voffA[1]}, vo2[2] = {s2b ? voffA2[0] : m2 ? voffAm[0] : voffA[0], s2b ? voffA2[1] : m2 ? voffAm[1] : voffA[1]};
            const char* a1h = m1 ? a1 - hstepA : a1 + hstepA; const char* a2h = m2 ? a2 - hstepA : a2 + hstepA;
            PG8_LDB(B0, 0, 0); PG8_LDB(B1, 0, 1); PG8_SCHED; PG8_LDA(At, 0, 0); PG8_STAGE(PG8_SA(1, 1), a1h, vo1);
            PG8_WAIT_V(8); PG8_WAIT_L(0); PG8_BAR; PG8_MMA(0, 0, At, B0); PG8_MMA(0, 1, At, B1); PG8_BAR; PG8_SCHED;
            PG8_LDA(At, 0, 1); PG8_STAGE(PG8_SB(0, 0), b2, voffB); PG8_STAGE(PG8_SB(0, 1), b2 + hstepB, voffB); PG8_STAGE(PG8_SA(0, 0), a2, vo2);
            PG8_WAIT_V(8); PG8_WAIT_L(0); PG8_BAR; PG8_MMA(1, 0, At, B0); PG8_MMA(1, 1, At, B1); PG8_BAR; PG8_SCHED;
            PG8_LDB(B0, 1, 0); PG8_LDB(B1, 1, 1); PG8_SCHED; PG8_LDA(At, 1, 0); PG8_STAGE(PG8_SA(0, 1), a2h, vo2);
            PG8_WAIT_V(8); PG8_WAIT_L(0); PG8_BAR; PG8_MMA(0, 0, At, B0); PG8_MMA(0, 1, At, B1); PG8_BAR; PG8_SCHED;
            PG8_LDA(At, 1, 1); PG8_STAGE(PG8_SB(1, 0), b3, voffB); PG8_STAGE(PG8_SB(1, 1), b3 + hstepB, voffB); PG8_STAGE(PG8_SA(1, 0), a3, vo2);
            PG8_WAIT_V(8); PG8_WAIT_L(0); PG8_BAR; PG8_MMA(1, 0, At, B0); PG8_MMA(1, 1, At, B1); PG8_BAR; PG8_SCHED;
        }
        if constexpr (ALIGN_EPI) { if (wr == 0) PG8_BAR; }
        E(acc, cur, wr, wc, fr, fq);
        if (!has_next) break;
#pragma unroll
        for (int a = 0; a < 2; ++a)
#pragma unroll
            for (int b = 0; b < 2; ++b)
#pragma unroll
                for (int m = 0; m < 4; ++m)
#pragma unroll
                    for (int n = 0; n < 2; ++n) acc[a][b][m][n] = (f32x4){0.f, 0.f, 0.f, 0.f};
        cur = nxt; cA = nA; cB = nB; mirC = mirN; if constexpr (SPLITA) cA2 = (const char*)g.A2 + (size_t)cur.pm * tstepA; ++ui;
        if constexpr (ALIGN_EPI) { if (wr == 1) PG8_BAR; }
    }
    PG8_WAIT_V(0);
    if constexpr (!ALIGN_EPI) { if (wr == 0) PG8_BAR; }
    PG8_BAR;
#undef PG8_SA
#undef PG8_SB
#undef PG8_STAGE
#undef PG8_LDA
#undef PG8_LDB
#undef PG8_MMA
#undef PG8_WAIT_V
#undef PG8_WAIT_L
#undef PG8_BAR
#undef PG8_SCHED
}

struct EpiFT {
    static constexpr bool KSUB = false; static constexpr bool KBLK = false; static constexpr bool MIDK = false;
    bf16_t* O;
    __device__ __forceinline__ void mid(Acc&, const Unit&, int, int, int, int) const {}
    __device__ __forceinline__ void operator()(const Acc& acc, const Unit& u, int wr, int wc, int fr, int fq) const {
        const int row0 = u.pm * BM + wr * 64 + fr, col0 = u.pb * 1024 + u.pn * 128 + wc * 32 + 8 * fq;
#pragma unroll
        for (int ai = 0; ai < 2; ++ai)
#pragma unroll
            for (int m = 0; m < 4; ++m) { bf16_t* rowp = O + (size_t)(row0 + ai * HALF + m * 16) * M + col0;
                *(u32x4*)(rowp) = pack8(acc[ai][0][m][0] + acc[ai][1][m][0], acc[ai][0][m][1] + acc[ai][1][m][1]);
                *(u32x4*)(rowp + NBATCH * 1024) = pack8(acc[ai][0][m][0] - acc[ai][1][m][0], acc[ai][0][m][1] - acc[ai][1][m][1]); }
    }
};
struct EpiDft {
    static constexpr bool KSUB = false; static constexpr bool KBLK = false; static constexpr bool MIDK = false;
    bf16_t* O;
    __device__ __forceinline__ void mid(Acc&, const Unit&, int, int, int, int) const {}
    __device__ __forceinline__ void operator()(const Acc& acc, const Unit& u, int wr, int wc, int fr, int fq) const {
        const int parity = u.pb / NBATCH, batch = u.pb - parity * NBATCH;
        const int r0 = u.pm * BM + wr * 64 + fr, col0 = u.pn * BM + wc * 32 + 8 * fq;
        bf16_t* base0 = O + (size_t)batch * SEQ * DM + col0;
#pragma unroll
        for (int ai = 0; ai < 2; ++ai)
#pragma unroll
            for (int m = 0; m < 4; ++m) { const int r = r0 + ai * HALF + m * 16, pq = r >> 9, k = 2 * (r & 511) + parity;
                bf16_t* base = base0 + pq * 512;
#pragma unroll
                for (int bj = 0; bj < 2; ++bj) { const u32x4 w = pack8(acc[ai][bj][m][0], acc[ai][bj][m][1]);
                    if (k != 0) { *(u32x4*)(base + (size_t)k * DM + bj * HALF) = w; }
                    else if (pq == 0) { *(u32x4*)(base + bj * HALF) = w; }
                    else { *(u32x4*)(base - 512 + (size_t)1024 * DM + bj * HALF) = w;
                           const u32x4 z = {0u, 0u, 0u, 0u}; *(u32x4*)(base + bj * HALF) = z; *(u32x4*)(base + (size_t)1024 * DM + bj * HALF) = z; } } }
    }
};
struct EpiG1 {
    static constexpr bool KSUB = false; static constexpr bool KBLK = false; static constexpr bool MIDK = false;
    bf16_t *QO, *KB, *VB, *G0; const float *ropec, *ropes; const LAS float* cst;
    __device__ __forceinline__ void mid(Acc&, const Unit&, int, int, int, int) const {}
    __device__ __forceinline__ void operator()(const Acc& acc, const Unit& u, int wr, int wc, int fr, int fq) const {
        const int row0 = u.pm * BM + wr * 64 + fr; const int pn = u.pn;
        if (pn < 8) {
            const bool isq = pn < 4; const int hm = 4 * (pn & 3) + wc; bf16_t* dst = (isq ? QO : KB) + hm * 64 + 8 * fq; const LAS float* g = cst + 2048 + (isq ? 0 : 64) + 8 * fq;
            const float sc = isq ? C2 : 1.0f;
            const f32x4 gl0 = *(const LAS f32x4*)(g), gl1 = *(const LAS f32x4*)(g + 4), gh0 = *(const LAS f32x4*)(g + 32), gh1 = *(const LAS f32x4*)(g + 36);
            const f32x4 k0 = *(const LAS f32x4*)(cst + 2176 + 8 * fq), k1 = *(const LAS f32x4*)(cst + 2176 + 8 * fq + 4);
            const f32x4 t0 = *(const LAS f32x4*)(cst + 2208 + 8 * fq), t1 = *(const LAS f32x4*)(cst + 2208 + 8 * fq + 4);
#pragma unroll
            for (int ai = 0; ai < 2; ++ai) {
                const int sb = (row0 + ai * HALF) & (SEQ - 1);
                f32x4 c0 = *(const f32x4*)(ropec + sb * 32 + 8 * fq), c1 = *(const f32x4*)(ropec + sb * 32 + 8 * fq + 4);
                f32x4 s0 = *(const f32x4*)(ropes + sb * 32 + 8 * fq), s1 = *(const f32x4*)(ropes + sb * 32 + 8 * fq + 4);
#pragma unroll
                for (int m = 0; m < 4; ++m) {
                    const int row = row0 + ai * HALF + m * 16;
                    if (m > 0) { const f32x4 nc0 = c0 * k0 - s0 * t0, ns0 = s0 * k0 + c0 * t0, nc1 = c1 * k1 - s1 * t1, ns1 = s1 * k1 + c1 * t1; c0 = nc0; s0 = ns0; c1 = nc1; s1 = ns1; }
                    const f32x4 a0 = acc[ai][0][m][0], a1 = acc[ai][0][m][1], b0 = acc[ai][1][m][0], b1 = acc[ai][1][m][1];
                    f32x4 q2 = a0 * a0 + a1 * a1 + b0 * b0 + b1 * b1; float ss = (q2[0] + q2[1]) + (q2[2] + q2[3]);
                    ss = quad_sum(ss);
                    const float rinv = __builtin_amdgcn_rsqf(ss * (1.0f / 64.0f) + EPS) * sc;
                    const f32x4 y00 = a0 * rinv * gl0, y01 = a1 * rinv * gl1, y10 = b0 * rinv * gh0, y11 = b1 * rinv * gh1;
                    const f32x4 o00 = y00 * c0 - y10 * s0, o01 = y01 * c1 - y11 * s1, o10 = y10 * c0 + y00 * s0, o11 = y11 * c1 + y01 * s1;
                    bf16_t* rowp = (isq ? QO : KB) + ((size_t)(row >> 4) * 32 + hm * 2) * 512 + (row & 15) * 32 + 8 * fq;
                    __builtin_nontemporal_store(pack8(o00, o01), (u32x4*)(rowp)); __builtin_nontemporal_store(pack8(o10, o11), (u32x4*)(rowp + 512));
                }
                asm volatile("" ::: "memory");
            }
        } else if (pn < 12) {
            const int col0 = (pn - 8) * BM + wc * 32 + 8 * fq;
#pragma unroll
            for (int ai = 0; ai < 2; ++ai)
#pragma unroll
                for (int m = 0; m < 4; ++m) { const int vrow = row0 + ai * HALF + m * 16; bf16_t* rowp = VB + ((size_t)(vrow >> 4) * 32 + (col0 >> 5)) * 512 + (vrow & 15) * 32 + (col0 & 31);
#pragma unroll
                    for (int bj = 0; bj < 2; ++bj) __builtin_nontemporal_store(pack8(acc[ai][bj][m][0], acc[ai][bj][m][1]), (u32x4*)(rowp + bj * (4 * 512))); }
        } else {
            const int col0 = (pn - 12) * 128 + wc * 32 + 8 * fq;
            const f32x4 ba0 = *(const LAS f32x4*)(cst + col0), ba1 = *(const LAS f32x4*)(cst + col0 + 4), bb0 = *(const LAS f32x4*)(cst + 1024 + col0), bb1 = *(const LAS f32x4*)(cst + 1024 + col0 + 4);
            const float NL2E = -1.4426950408889634f;
#pragma unroll
            for (int ai = 0; ai < 2; ++ai)
#pragma unroll
                for (int m = 0; m < 4; ++m) {
                    const int grow = row0 + ai * HALF + m * 16;
                    const size_t off = ((size_t)(grow >> 4) * 32 + (col0 >> 5)) * 512 + (grow & 15) * 32 + (col0 & 31);
                    f32x4 z0[2] = {acc[ai][0][m][0] + ba0, acc[ai][0][m][1] + ba1}, z1[2] = {acc[ai][1][m][0] + bb0, acc[ai][1][m][1] + bb1};
                    u32x4 w = {0u, 0u, 0u, 0u}; const float C255 = 1.0f / 255.0f;
#pragma unroll
                    for (int n = 0; n < 2; ++n)
#pragma unroll
                        for (int e = 0; e < 4; ++e) {
                            const float e0 = __builtin_amdgcn_exp2f(fminf(z0[n][e] * NL2E, 40.f)), e1 = __builtin_amdgcn_exp2f(fminf(z1[n][e] * NL2E, 40.f));
                            const float q0 = fmaxf(__builtin_amdgcn_rcpf(__builtin_fmaf(e0, C255, C255)) + 0.5f, 1.0f), q1 = __builtin_amdgcn_rcpf(__builtin_fmaf(e1, C255, C255)) + 0.5f;
                            w[n] = __builtin_amdgcn_cvt_pk_u8_f32(q0, (unsigned)e, w[n]); w[2 + n] = __builtin_amdgcn_cvt_pk_u8_f32(q1, (unsigned)e, w[2 + n]); }
                    __builtin_nontemporal_store(w, (u32x4*)(G0 + off));
                }
        }
    }
};
struct EpiMix {
    static constexpr bool KSUB = false; static constexpr bool KBLK = false; static constexpr bool MIDK = true;
    const bf16_t* G0; bf16_t* O;
    template <int MODE> __device__ __forceinline__ void scale(Acc& acc, const Unit& u, int wr, int wc, int fr, int fq) const {
        int row0 = u.pm * BM + wr * 64 + fr; const int col0 = u.pn * BM + wc * 32 + 8 * fq;
        asm volatile("" : "+v"(row0));
        u32x4 gv[2][4][2];
#pragma unroll
        for (int ai = 0; ai < 2; ++ai)
#pragma unroll
            for (int m = 0; m < 4; ++m)
#pragma unroll
                for (int bj = 0; bj < 2; ++bj) { const int grow = row0 + ai * HALF + m * 16, gcol = col0 + bj * HALF;
                    const bf16_t* gp = G0 + ((size_t)(grow >> 4) * 32 + (gcol >> 5)) * 512 + (grow & 15) * 32 + (gcol & 31);
                    if (MODE == 0) gv[ai][m][bj] = *(const u32x4*)gp;
                    else { const u32x2 h = __builtin_nontemporal_load((const u32x2*)gp); gv[ai][m][bj] = (u32x4){h.x, h.y, 0u, 0u}; } }
        asm volatile("" ::: "memory");
#pragma unroll
        for (int ai = 0; ai < 2; ++ai)
#pragma unroll
            for (int m = 0; m < 4; ++m)
#pragma unroll
                for (int bj = 0; bj < 2; ++bj)
#pragma unroll
                    for (int n = 0; n < 2; ++n)
#pragma unroll
                        for (int e = 0; e < 4; ++e) { const float q0 = (float)((gv[ai][m][bj][n] >> (8 * e)) & 255u);
                            if (MODE == 0) { const float q1 = (float)((gv[ai][m][bj][2 + n] >> (8 * e)) & 255u); acc[ai][bj][m][n][e] *= q1 * __builtin_amdgcn_rcpf(q0); }
                            else acc[ai][bj][m][n][e] *= q0 * (1.0f / 255.0f); }
        asm volatile("" ::: "memory");
    }
    __device__ __forceinline__ void mid(Acc& acc, const Unit& u, int wr, int wc, int fr, int fq) const { scale<0>(acc, u, wr, wc, fr, fq); }
    __device__ __forceinline__ void operator()(Acc& acc, const Unit& u, int wr, int wc, int fr, int fq) const {
        scale<1>(acc, u, wr, wc, fr, fq);
        const int row0 = u.pm * BM + wr * 64 + fr, col0 = u.pn * BM + wc * 32 + 8 * fq;
#pragma unroll
        for (int ai = 0; ai < 2; ++ai)
#pragma unroll
            for (int m = 0; m < 4; ++m) { bf16_t* rowp = O + (size_t)u.pm * (BM * DM) + (size_t)u.pn * (BM * BM) + (size_t)((((row0 + ai * HALF + m * 16) & (BM - 1)) >> 4) * 8 + wc) * 512 + fr * 32 + 8 * fq;
#pragma unroll
                for (int bj = 0; bj < 2; ++bj) *(u32x4*)(rowp + bj * (4 * 512)) = pack8(acc[ai][bj][m][0], acc[ai][bj][m][1]); }
    }
};
struct EpiOut {
    static constexpr bool KSUB = true;  static constexpr bool KBLK = true;  static constexpr bool MIDK = false;
    const float* xn; bf16_t* X1B; float* ssq;
    __device__ __forceinline__ void mid(Acc&, const Unit&, int, int, int, int) const {}
    __device__ __forceinline__ void operator()(const Acc& acc, const Unit& u, int wr, int wc, int fr, int fq) const {
        const int row0 = u.pm * BM + wr * 64 + fr, col0 = u.pn * BM + wc * 32 + 8 * fq;
#pragma unroll
        for (int ai = 0; ai < 2; ++ai) {
            u32x4 xw[4][2]; float nr[4];
#pragma unroll
            for (int m = 0; m < 4; ++m) { nr[m] = xn[row0 + ai * HALF + m * 16];
#pragma unroll
                for (int bj = 0; bj < 2; ++bj) xw[m][bj] = *(const u32x4*)(X1B + (size_t)(row0 + ai * HALF + m * 16) * DM + col0 + bj * HALF); }
#pragma unroll
            for (int m = 0; m < 4; ++m) {
                const int row = row0 + ai * HALF + m * 16; const size_t off = (size_t)row * DM + col0; float ss = 0.f;
#pragma unroll
                for (int bj = 0; bj < 2; ++bj) {
                    f32x4 xa, xb2; unpack8(xw[m][bj], xa, xb2);
                    const f32x4 v0 = xa * nr[m] + acc[ai][bj][m][0], v1 = xb2 * nr[m] + acc[ai][bj][m][1];
                    *(u32x4*)(X1B + off + bj * HALF) = pack8(v0, v1);
                    const f32x4 q = v0 * v0 + v1 * v1; ss += (q[0] + q[1]) + (q[2] + q[3]); }
                ss = quad_sum(ss);
                if (fq == 0) atomicAdd(ssq + row, ss);
            }
            asm volatile("" ::: "memory");
        }
    }
};
struct EpiUp {
    static constexpr bool KSUB = false; static constexpr bool KBLK = false; static constexpr bool MIDK = false;
    const float* ssq; bf16_t* U;
    __device__ __forceinline__ void mid(Acc&, const Unit&, int, int, int, int) const {}
    __device__ __forceinline__ void operator()(const Acc& acc, const Unit& u, int wr, int wc, int fr, int fq) const {
        const int row0 = u.pm * BM + wr * 64 + fr, col0 = u.pn * BM + wc * 32 + 8 * fq;
#pragma unroll
        for (int ai = 0; ai < 2; ++ai)
#pragma unroll
            for (int m = 0; m < 4; ++m) {
                const int row = row0 + ai * HALF + m * 16; const float rinv = __builtin_amdgcn_rsqf(ssq[row] * (1.0f / DM) + EPS);
                bf16_t* rowp = U + (size_t)u.pm * (BM * FF) + (size_t)u.pn * (BM * BM) + (size_t)(((row & (BM - 1)) >> 4) * 8 + wc) * 512 + fr * 32 + 8 * fq;
#pragma unroll
                for (int bj = 0; bj < 2; ++bj) { f32x4 v0 = acc[ai][bj][m][0] * rinv, v1 = acc[ai][bj][m][1] * rinv;
#pragma unroll
                    for (int e = 0; e < 4; ++e) { const float a = fmaxf(v0[e], 0.f), b = fmaxf(v1[e], 0.f); v0[e] = a * a; v1[e] = b * b; }
                    __builtin_nontemporal_store(pack8(v0, v1), (u32x4*)(rowp + bj * (4 * 512))); }
            }
    }
};
struct EpiDown {
    static constexpr bool KSUB = true; static constexpr bool KBLK = true; static constexpr bool MIDK = false;
    float* out; const bf16_t* X1B;
    __device__ __forceinline__ void mid(Acc&, const Unit&, int, int, int, int) const {}
    __device__ __forceinline__ void operator()(const Acc& acc, const Unit& u, int wr, int wc, int fr, int fq) const {
        const int row0 = u.pm * BM + wr * 64 + fr, col0 = u.pn * BM + wc * 32 + 8 * fq;
#pragma unroll
        for (int ai = 0; ai < 2; ++ai) {
            u32x4 xv[4][2];
#pragma unroll
            for (int m = 0; m < 4; ++m)
#pragma unroll
                for (int bj = 0; bj < 2; ++bj) xv[m][bj] = *(const u32x4*)(X1B + (size_t)(row0 + ai * HALF + m * 16) * DM + col0 + bj * HALF);
#pragma unroll
            for (int m = 0; m < 4; ++m)
#pragma unroll
                for (int bj = 0; bj < 2; ++bj) { float* rowp = out + (size_t)(row0 + ai * HALF + m * 16) * DM + col0 + bj * HALF; f32x4 a, b; unpack8(xv[m][bj], a, b);
                    __builtin_nontemporal_store(a + acc[ai][bj][m][0], (f32x4*)(rowp)); __builtin_nontemporal_store(b + acc[ai][bj][m][1], (f32x4*)(rowp + 4)); }
            asm volatile("" ::: "memory");
        }
    }
};
}

namespace att {
constexpr int KVBLK = 64, NT = SEQ / KVBLK, QB = 256;
constexpr int KSLOT = 8192, VSLOT = 16384, NSLOT = 3;
constexpr int LDS_K = 0, LDS_V = NSLOT * KSLOT, LDS_ST = LDS_V + NSLOT * VSLOT, LDS_WS = LDS_ST + 8 * 8192, LDS_END = LDS_WS + 8 * 256;
static_assert(LDS_END <= RING_BYTES + 12288, "attention LDS");
typedef LAS const char* lds_cptr;
typedef short v4i16_t __attribute__((ext_vector_type(4)));
__device__ __forceinline__ int crow(int r, int hi) { return (r & 3) + 8 * (r >> 2) + 4 * hi; }
__device__ __forceinline__ void glds16(const void* gsrc, unsigned lds_dst) { unsigned keep;
    asm volatile("s_mov_b32 %0, m0\n\ts_mov_b32 m0, %2\n\ts_nop 0\n\tglobal_load_lds_dwordx4 %1, off\n\ts_mov_b32 m0, %0" : "=&s"(keep) : "v"(gsrc), "s"(lds_dst) : "memory"); }
__device__ __forceinline__ s16x4 vtr(lds_cptr p) { return __builtin_bit_cast(s16x4, __builtin_amdgcn_ds_read_tr16_b64_v4i16((LAS v4i16_t*)p)); }
__device__ __forceinline__ void kload2(bf16x8* kf, lds_cptr kp, int j) { kf[2 * j] = *(const LAS bf16x8*)(kp + j * 2048); kf[2 * j + 1] = *(const LAS bf16x8*)(kp + j * 2048 + 512); }
#define ATT_WAIT_BAR(N) asm volatile("s_waitcnt vmcnt(" #N ") lgkmcnt(0)\n\ts_barrier" ::: "memory")
#define ATT_SB() __builtin_amdgcn_sched_barrier(0)
#define ATT_PIN(x) asm volatile("" : "+v"(x))
#define ATT_MFMA(a, b, c) __builtin_amdgcn_mfma_f32_32x32x16_bf16(a, b, c, 0, 0, 0)
#define ATT_PK(lo, hi) pg8::cvt_pk_bf16(lo, hi)

__device__ __forceinline__ void attn_unit(int b, int h, int qb, bool first, bool has_next, int nb, int nh, bf16_t* QO, const bf16_t* __restrict__ K, const bf16_t* __restrict__ V, float lam, char* shm) {
    int tid = threadIdx.x; asm volatile("" : "+v"(tid));
    const int lane = tid & 63, r32 = lane & 31, hi = lane >> 5; const int wid = __builtin_amdgcn_readfirstlane(tid >> 6);
    const long rowbase = (long)b * SEQ; const int q0 = qb * QB;
    const unsigned lds0 = (unsigned)(uintptr_t)shm;
    const long klane = (long)((lane >> 4) * 32 + (wid >> 2)) * 512 + (lane & 15) * 32 + (wid & 3) * 8;
    const long vlane = (long)((wid & 3) * 32 + (wid >> 2)) * 512 + (lane >> 2) * 32 + (lane & 3) * 8;
    const bf16_t* vsrc0 = V + rowbase * DM + h * 2048 + vlane;
    const unsigned vdst = lds0 + LDS_V + wid * 1024, kdst = lds0 + LDS_K + wid * 1024;
    const lds_cptr shm3 = (lds_cptr)shm;
    const lds_cptr vp0 = shm3 + LDS_V + ((lane >> 4) & 1) * 32 + (lane & 3) * 8 + (4 * hi + ((lane & 15) >> 2)) * 64;
    const lds_cptr kp0 = shm3 + LDS_K + hi * 1024 + r32 * 16;
    f32x16 o[4];
#pragma unroll 1
    for (int map = 0; map < 2; ++map) {
        const int hm = 2 * h + map;
        const bf16_t* ksrc = K + rowbase * DM + hm * 1024 + klane;
        const bf16_t* Qw = QO + (rowbase + q0 + wid * 32) * DM + hm * 1024;
        bf16x8 qr[4];
#pragma unroll
        for (int d0 = 0; d0 < 4; ++d0) qr[d0] = *reinterpret_cast<const bf16x8*>(&Qw[(long)((r32 >> 4) * 32 + (d0 >> 1)) * 512 + (r32 & 15) * 32 + (d0 & 1) * 16 + hi * 8]);
#define DMA_K(t, slot) glds16(ksrc + (long)(t) * KVBLK * DM, (unsigned)__builtin_amdgcn_readfirstlane(kdst + (slot) * KSLOT))
#define DMA_V(t, slot) do { glds16(vsrc0 + (long)(t) * KVBLK * DM, (unsigned)__builtin_amdgcn_readfirstlane(vdst + (slot) * VSLOT)); \
        glds16(vsrc0 + (long)(t) * KVBLK * DM + 1024, (unsigned)__builtin_amdgcn_readfirstlane(vdst + (slot) * VSLOT + 8192)); } while (0)
        if (map == 0 && first) { DMA_K(0, 0); DMA_V(0, 0); DMA_K(1, 1); DMA_K(2, 2); }
        float l_reg = 0.f;
#pragma unroll
        for (int d0 = 0; d0 < 4; ++d0) o[d0] = f32x16{};
        f32x16 pA0, pA1, pB0, pB1; bf16x8 kf[8]; s16x4 vlo[4], vhi[4]; u32x4 pw0, pw1, pw2, pw3;
        int sl_prev = 0, sl_cur = 0, sl_next = 1;
#define ROT() do { sl_prev = sl_cur; sl_cur = sl_next; sl_next = (sl_next == 2) ? 0 : sl_next + 1; } while (0)
        ATT_WAIT_BAR(4);
        { const lds_cptr kp = kp0; pA0 = f32x16{}; pA1 = f32x16{};
#pragma unroll
          for (int d0 = 0; d0 < 4; ++d0) { const bf16x8 k0 = *(const LAS bf16x8*)(kp + d0 * 2048), k1 = *(const LAS bf16x8*)(kp + d0 * 2048 + 512);
              pA0 = ATT_MFMA(k0, qr[d0], pA0); pA1 = ATT_MFMA(k1, qr[d0], pA1); }
#pragma unroll
          for (int r = 0; r < 16; ++r) { pA0[r] = __builtin_amdgcn_exp2f(pA0[r]); pA1[r] = __builtin_amdgcn_exp2f(pA1[r]); }
          ATT_PIN(pA0); ATT_PIN(pA1); }
        ATT_SB();
        ATT_WAIT_BAR(0);
        DMA_K(3, 0); DMA_V(1, 1);
        ROT();
#pragma unroll
        for (int j = 0; j < 4; ++j) kload2(kf, kp0 + sl_cur * KSLOT, j);
        ATT_WAIT_BAR(3);
#define VOFF(j) ((((j) & 3) * 4096) + (((j) >> 2) * 1024))
#define VRD(j) do { vlo[(j) & 3] = vtr(vp_ + VOFF(j)); vhi[(j) & 3] = vtr(vp_ + VOFF(j) + 512); } while (0)
#define VFR(j) (bf16x8){vlo[(j) & 3][0], vlo[(j) & 3][1], vlo[(j) & 3][2], vlo[(j) & 3][3], vhi[(j) & 3][0], vhi[(j) & 3][1], vhi[(j) & 3][2], vhi[(j) & 3][3]}
#define PAF(k) __builtin_bit_cast(bf16x8, pw##k)
#define EX(v) __builtin_amdgcn_exp2f(v)
#define GAPA(MF, A0, A1, A2, A3, W0, W1, PW) do { MF; sacc += A0; sacc += A1; sacc += A2; sacc += A3; ATT_PIN(sacc); W0; W1; ATT_PIN(PW); ATT_SB(); } while (0)
#define GAPB(MF, X, B, RD) do { MF; X[B] = EX(X[B]); X[B + 1] = EX(X[B + 1]); ATT_PIN(X); RD; ATT_SB(); } while (0)
#define KRD(G, j) do { if (G) { kload2(kf, kp0 + sl_next * KSLOT, j); } } while (0)
#define NOP_ do { } while (0)
#define STEP(C0, C1, P0, P1, t, GK, GV, GL) do { ATT_SB(); \
        const lds_cptr vp_ = vp0 + sl_prev * VSLOT; \
        VRD(0); ATT_SB(); float sacc = (P0[0] + P0[1]); \
        GAPA(C0 = ATT_MFMA(kf[0], qr[0], (f32x16{})), P0[2], P0[3], P0[4], P0[5],     pw0[0] = ATT_PK(P0[0], P0[1]),   pw0[1] = ATT_PK(P0[2], P0[3]),   pw0); \
        VRD(1); ATT_SB(); GAPA(C1 = ATT_MFMA(kf[1], qr[0], (f32x16{})), P0[6], P0[7], P0[8], P0[9],     pw0[2] = ATT_PK(P0[4], P0[5]),   pw0[3] = ATT_PK(P0[6], P0[7]),   pw0); \
        VRD(2); ATT_SB(); GAPA(C0 = ATT_MFMA(kf[2], qr[1], C0),          P0[10], P0[11], P0[12], P0[13], pw1[0] = ATT_PK(P0[8], P0[9]),   pw1[1] = ATT_PK(P0[10], P0[11]), pw1); \
        VRD(3); ATT_SB(); GAPA(C1 = ATT_MFMA(kf[3], qr[1], C1),          P0[14], P0[15], P1[0], P1[1],   pw1[2] = ATT_PK(P0[12], P0[13]), pw1[3] = ATT_PK(P0[14], P0[15]), pw1); \
        GAPA(C0 = ATT_MFMA(kf[4], qr[2], C0),          P1[2], P1[3], P1[4], P1[5],     pw2[0] = ATT_PK(P1[0], P1[1]),   pw2[1] = ATT_PK(P1[2], P1[3]),   pw2); \
        GAPA(C1 = ATT_MFMA(kf[5], qr[2], C1),          P1[6], P1[7], P1[8], P1[9],     pw2[2] = ATT_PK(P1[4], P1[5]),   pw2[3] = ATT_PK(P1[6], P1[7]),   pw2); \
        GAPA(C0 = ATT_MFMA(kf[6], qr[3], C0),          P1[10], P1[11], P1[12], P1[13], pw3[0] = ATT_PK(P1[8], P1[9]),   pw3[1] = ATT_PK(P1[10], P1[11]), pw3); \
        GAPA(C1 = ATT_MFMA(kf[7], qr[3], C1),          P1[14], P1[15], 0.f, 0.f,       pw3[2] = ATT_PK(P1[12], P1[13]), pw3[3] = ATT_PK(P1[14], P1[15]), pw3); \
        l_reg += sacc; \
        if (GK) { DMA_K((t) + 3, sl_cur); } if (GV) { DMA_V((t) + 1, sl_next); } \
        ATT_SB(); \
        GAPB(o[0] = ATT_MFMA(PAF(0), VFR(0), o[0]),   C0, 0,  VRD(4)); \
        GAPB(o[1] = ATT_MFMA(PAF(0), VFR(1), o[1]),   C0, 2,  VRD(5)); \
        GAPB(o[2] = ATT_MFMA(PAF(0), VFR(2), o[2]),   C0, 4,  VRD(6)); \
        GAPB(o[3] = ATT_MFMA(PAF(0), VFR(3), o[3]),   C0, 6,  VRD(7)); \
        GAPB(o[0] = ATT_MFMA(PAF(1), VFR(4), o[0]),   C0, 8,  VRD(8)); \
        GAPB(o[1] = ATT_MFMA(PAF(1), VFR(5), o[1]),   C0, 10, VRD(9)); \
        KRD(GL, 0); GAPB(o[2] = ATT_MFMA(PAF(1), VFR(6), o[2]),   C0, 12, VRD(10)); \
        GAPB(o[3] = ATT_MFMA(PAF(1), VFR(7), o[3]),   C0, 14, VRD(11)); \
        KRD(GL, 1); GAPB(o[0] = ATT_MFMA(PAF(2), VFR(8), o[0]),   C1, 0,  VRD(12)); \
        GAPB(o[1] = ATT_MFMA(PAF(2), VFR(9), o[1]),   C1, 2,  VRD(13)); \
        KRD(GL, 2); GAPB(o[2] = ATT_MFMA(PAF(2), VFR(10), o[2]),  C1, 4,  VRD(14)); \
        GAPB(o[3] = ATT_MFMA(PAF(2), VFR(11), o[3]),  C1, 6,  VRD(15)); \
        KRD(GL, 3); GAPB(o[0] = ATT_MFMA(PAF(3), VFR(12), o[0]),  C1, 8,  NOP_); \
        GAPB(o[1] = ATT_MFMA(PAF(3), VFR(13), o[1]),  C1, 10, NOP_); \
        GAPB(o[2] = ATT_MFMA(PAF(3), VFR(14), o[2]),  C1, 12, NOP_); \
        GAPB(o[3] = ATT_MFMA(PAF(3), VFR(15), o[3]),  C1, 14, NOP_); \
        } while (0)
        int t = 1;
#pragma unroll 1
        for (; t + 1 <= NT - 4; t += 2) {
            STEP(pB0, pB1, pA0, pA1, t, true, true, true);     ATT_WAIT_BAR(3); ROT();
            STEP(pA0, pA1, pB0, pB1, t + 1, true, true, true); ATT_WAIT_BAR(3); ROT();
        }
        STEP(pB0, pB1, pA0, pA1, NT - 3, false, true, true);   ATT_WAIT_BAR(2); ROT();
        STEP(pA0, pA1, pB0, pB1, NT - 2, false, true, true);   ATT_WAIT_BAR(0); ROT();
        STEP(pB0, pB1, pA0, pA1, NT - 1, false, false, false);
        { float sacc = pB0[0] + pB0[1];
#pragma unroll
          for (int r = 2; r < 16; ++r) sacc += pB0[r];
#pragma unroll
          for (int r = 0; r < 16; ++r) sacc += pB1[r];
          l_reg += sacc;
          pw0 = (u32x4){ATT_PK(pB0[0], pB0[1]), ATT_PK(pB0[2], pB0[3]), ATT_PK(pB0[4], pB0[5]), ATT_PK(pB0[6], pB0[7])};
          pw1 = (u32x4){ATT_PK(pB0[8], pB0[9]), ATT_PK(pB0[10], pB0[11]), ATT_PK(pB0[12], pB0[13]), ATT_PK(pB0[14], pB0[15])};
          pw2 = (u32x4){ATT_PK(pB1[0], pB1[1]), ATT_PK(pB1[2], pB1[3]), ATT_PK(pB1[4], pB1[5]), ATT_PK(pB1[6], pB1[7])};
          pw3 = (u32x4){ATT_PK(pB1[8], pB1[9]), ATT_PK(pB1[10], pB1[11]), ATT_PK(pB1[12], pB1[13]), ATT_PK(pB1[14], pB1[15])};
          ATT_SB();
          const lds_cptr vp = vp0 + sl_cur * VSLOT;
#pragma unroll
          for (int d0 = 0; d0 < 4; ++d0) {
              const s16x4 l0 = vtr(vp + d0 * 4096), h0 = vtr(vp + d0 * 4096 + 512), l1 = vtr(vp + d0 * 4096 + 1024), h1 = vtr(vp + d0 * 4096 + 1536);
              const s16x4 l2 = vtr(vp + d0 * 4096 + 2048), h2 = vtr(vp + d0 * 4096 + 2560), l3 = vtr(vp + d0 * 4096 + 3072), h3 = vtr(vp + d0 * 4096 + 3584);
              o[d0] = ATT_MFMA(PAF(0), ((bf16x8){l0[0], l0[1], l0[2], l0[3], h0[0], h0[1], h0[2], h0[3]}), o[d0]);
              o[d0] = ATT_MFMA(PAF(1), ((bf16x8){l1[0], l1[1], l1[2], l1[3], h1[0], h1[1], h1[2], h1[3]}), o[d0]);
              o[d0] = ATT_MFMA(PAF(2), ((bf16x8){l2[0], l2[1], l2[2], l2[3], h2[0], h2[1], h2[2], h2[3]}), o[d0]);
              o[d0] = ATT_MFMA(PAF(3), ((bf16x8){l3[0], l3[1], l3[2], l3[3], h3[0], h3[1], h3[2], h3[3]}), o[d0]); } }
#undef STEP
#undef GAPA
#undef GAPB
#undef KRD
#undef NOP_
#undef VRD
#undef VFR
#undef VOFF
#undef PAF
#undef EX
#undef ROT
#undef DMA_K
#undef DMA_V
        ATT_SB();
        asm volatile("s_waitcnt lgkmcnt(0)\n\ts_barrier" ::: "memory");
        ATT_SB();
        if (map == 0 || has_next) {
            const bf16_t* nk = (map == 0) ? ksrc + 1024 : K + (long)nb * SEQ * DM + (2 * nh) * 1024 + klane;
            const bf16_t* nv = (map == 0) ? vsrc0 : V + (long)nb * SEQ * DM + nh * 2048 + vlane;
            glds16(nk, (unsigned)__builtin_amdgcn_readfirstlane(kdst)); glds16(nv, (unsigned)__builtin_amdgcn_readfirstlane(vdst)); glds16(nv + 1024, (unsigned)__builtin_amdgcn_readfirstlane(vdst + 8192));
            glds16(nk + (long)KVBLK * DM, (unsigned)__builtin_amdgcn_readfirstlane(kdst + KSLOT)); glds16(nk + 2L * KVBLK * DM, (unsigned)__builtin_amdgcn_readfirstlane(kdst + 2 * KSLOT)); }
        ATT_SB();
        { auto rr = __builtin_amdgcn_permlane32_swap(__float_as_uint(l_reg), __float_as_uint(l_reg), false, false); l_reg = __uint_as_float(rr[0]) + __uint_as_float(rr[1]); }
        int elane = lane; asm volatile("" : "+v"(elane));
        const int er32 = elane & 31, ehi = elane >> 5;
        float* wsf = (float*)(shm + LDS_WS) + wid * 64;
        u32x4* stash = (u32x4*)(shm + LDS_ST + wid * 8192);
        if (ehi == 0) wsf[er32] = l_reg;
        asm volatile("s_waitcnt lgkmcnt(0)" ::: "memory");
        float rli[16];
#pragma unroll
        for (int r = 0; r < 16; ++r) rli[r] = __builtin_amdgcn_rcpf(wsf[crow(r, ehi)]);
        asm volatile("s_waitcnt lgkmcnt(0)" ::: "memory");
        if (map == 0) {
#pragma unroll
            for (int d0 = 0; d0 < 4; ++d0)
#pragma unroll
                for (int i = 0; i < 2; ++i) { u32x4 w;
#pragma unroll
                    for (int j = 0; j < 4; ++j) { const int r = 8 * i + 2 * j; w[j] = pg8::cvt_pk_bf16(o[d0][r] * rli[r], o[d0][r + 1] * rli[r + 1]); }
                    stash[(d0 * 2 + i) * 64 + elane] = w; }
        } else {
            float ssr[16];
#pragma unroll
            for (int r = 0; r < 16; ++r) ssr[r] = 0.f;
#pragma unroll
            for (int d0 = 0; d0 < 4; ++d0)
#pragma unroll
                for (int i = 0; i < 2; ++i) { const u32x4 w = stash[(d0 * 2 + i) * 64 + elane];
#pragma unroll
                    for (int j = 0; j < 4; ++j) { const int r = 8 * i + 2 * j;
                        const float a = __uint_as_float(w[j] << 16) - lam * (o[d0][r] * rli[r]), c = __uint_as_float(w[j] & 0xffff0000u) - lam * (o[d0][r + 1] * rli[r + 1]);
                        o[d0][r] = a; o[d0][r + 1] = c; ssr[r] += a * a; ssr[r + 1] += c * c; } }
#pragma unroll
            for (int r = 0; r < 16; ++r) {
#pragma unroll
                for (int off = 1; off < 32; off <<= 1) ssr[r] += __shfl_xor(ssr[r], off);
                ssr[r] = __builtin_amdgcn_rsqf(ssr[r] * (1.0f / 128.0f) + EPS); }
            asm volatile("s_waitcnt lgkmcnt(0)" ::: "memory");
            bf16_t* stg = (bf16_t*)stash;
#pragma unroll
            for (int d0 = 0; d0 < 4; ++d0)
#pragma unroll
                for (int r = 0; r < 16; ++r) { const unsigned pk = pg8::cvt_pk_bf16(o[d0][r] * ssr[r], 0.f); stg[crow(r, ehi) * 128 + d0 * 32 + er32] = (bf16_t)(pk & 0xffffu); }
            asm volatile("s_waitcnt lgkmcnt(0)" ::: "memory");
            bf16_t* Ow = QO + (rowbase + q0 + wid * 32) * DM + h * 2048;
#pragma unroll
            for (int i = 0; i < 8; ++i) { const int row = i * 4 + (elane >> 4), ch = elane & 15; const u32x4 v = *(const u32x4*)(stg + row * 128 + ch * 8); *(u32x4*)(Ow + (long)((row >> 4) * 32 + (ch >> 2)) * 512 + (row & 15) * 32 + (ch & 3) * 8) = v; }
            asm volatile("s_waitcnt lgkmcnt(0)" ::: "memory");
        }
    }
}
#undef ATT_WAIT_BAR
#undef ATT_SB
#undef ATT_PIN
#undef ATT_MFMA
#undef ATT_PK
}

__device__ __forceinline__ float wave_sum(float v) {
#pragma unroll
    for (int o = 1; o < 64; o <<= 1) v += __shfl_xor(v, o);
    return v;
}
__device__ __forceinline__ void p0_transpose_item(const float* src, int ldn, int scol0, int k0, const float* ks, int kmask, float cs, bf16_t* dst, int drow0, int dld, int dk0, LAS float* scr, int lane, bool chunk = false, bool nts = false) {
    f32x4 v[8]; float sc[8];
#pragma unroll
    for (int i = 0; i < 8; ++i) { const int kk = 8 * i + (lane >> 3); v[i] = __builtin_nontemporal_load((const f32x4*)(src + (size_t)(k0 + kk) * ldn + scol0 + (lane & 7) * 4)); sc[i] = ks ? ks[(k0 + kk) & kmask] * cs : cs; }
#pragma unroll
    for (int i = 0; i < 8; ++i) { const int kk = 8 * i + (lane >> 3); LAS float* d = scr + kk * 33 + (lane & 7) * 4; d[0] = v[i][0] * sc[i]; d[1] = v[i][1] * sc[i]; d[2] = v[i][2] * sc[i]; d[3] = v[i][3] * sc[i]; }
    asm volatile("s_waitcnt lgkmcnt(0)" ::: "memory");
    const int c = lane & 7;
#pragma unroll
    for (int j = 0; j < 4; ++j) { const int n = (lane >> 3) + 8 * j; const LAS float* s = scr + (8 * c) * 33 + n;
        u32x4 o; o.x = pg8::cvt_pk_bf16(s[0 * 33], s[1 * 33]); o.y = pg8::cvt_pk_bf16(s[2 * 33], s[3 * 33]); o.z = pg8::cvt_pk_bf16(s[4 * 33], s[5 * 33]); o.w = pg8::cvt_pk_bf16(s[6 * 33], s[7 * 33]);
        const int drow = drow0 + n, dcol = dk0 + k0 + 8 * c;
        u32x4* dp = (u32x4*)(dst + (chunk ? ((size_t)(drow >> 4) * (dld >> 5) + (dcol >> 5)) * 512 + (drow & 15) * 32 + (dcol & 31) : (size_t)drow * dld + dcol));
        if (nts) __builtin_nontemporal_store(o, dp); else *dp = o; }
    asm volatile("s_waitcnt lgkmcnt(0)" ::: "memory");
}
__device__ const double ROPE_F[32] = {
    0.15915494309189535, 0.11934937021124886, 0.08949940160889101, 0.06711508300522726, 0.050329212104487035, 0.03774158471741977, 0.0283021958306234, 0.02122365276477766,
    0.015915494309189534, 0.011934937021124886, 0.008949940160889102, 0.006711508300522725, 0.005032921210448704, 0.003774158471741977, 0.00283021958306234, 0.0021223652764777662,
    0.0015915494309189536, 0.0011934937021124885, 0.0008949940160889102, 0.0006711508300522726, 0.0005032921210448703, 0.00037741584717419774, 0.00028302195830623395, 0.0002122365276477766,
    0.00015915494309189535, 0.00011934937021124886, 8.949940160889102e-05, 6.711508300522725e-05, 5.0329212104487035e-05, 3.774158471741978e-05, 2.8302195830623396e-05, 2.122365276477766e-05};

#define XB_TMO      128
#define XB_XCNT(j)  (256  + 64 * (j))
#define XB_XSUB(j)  (1280 + 64 * (j))
#define XB_XGEN(j)  (2304 + 64 * (j))
#define XB_TOP      3328
#define XB_TOPGEN   3392
#define XCD_BAR_WORDS 3456
#define XB_SPIN_CAP (1u << 18)
__device__ __forceinline__ unsigned xb_ld(unsigned* p)              { return __hip_atomic_load(p, __ATOMIC_RELAXED, __HIP_MEMORY_SCOPE_AGENT); }
__device__ __forceinline__ unsigned xb_add(unsigned* p, unsigned v) { return __hip_atomic_fetch_add(p, v, __ATOMIC_RELAXED, __HIP_MEMORY_SCOPE_AGENT); }
__device__ __forceinline__ unsigned xb_xcc_id() { return (unsigned)__builtin_amdgcn_s_getreg((3 << 11) | 20) & 0xFu; }
#define XB_SPIN(cond, bar) do { unsigned _sp = 0; while (cond) { __builtin_amdgcn_s_sleep(1); \
    if ((++_sp & 255u) == 0u) { if (xb_ld(&(bar)[XB_TMO])) break; if (_sp > XB_SPIN_CAP) { atomicAdd(&(bar)[XB_TMO], 1u); break; } } } } while (0)
struct XcdBarrier { unsigned* bar; unsigned x; volatile LAS unsigned* st; };
__device__ __forceinline__ XcdBarrier xcd_barrier_post(unsigned* bar, volatile LAS unsigned* st) {
    XcdBarrier b; b.bar = bar; b.x = xb_xcc_id(); b.st = st;
    if (threadIdx.x == 0) (void)xb_add(&bar[XB_XCNT(b.x)], 1u);
    return b;
}
__device__ __forceinline__ void xcd_barrier_complete(unsigned* bar, unsigned x, unsigned& nloc, unsigned& nx) {
    const unsigned G = gridDim.x * gridDim.y * gridDim.z;
    unsigned sum, cnt, mine, sp = 0u;
    for (;;) {
        sum = 0u; cnt = 0u; mine = 0u;
#pragma unroll
        for (unsigned j = 0; j < 16; ++j) { const unsigned c = xb_ld(&bar[XB_XCNT(j)]); sum += c; cnt += (c > 0u) ? 1u : 0u; mine = (j == x) ? c : mine; }
        if (sum == G) break;
        __builtin_amdgcn_s_sleep(1);
        if ((++sp & 255u) == 0u) { if (xb_ld(&bar[XB_TMO])) break; if (sp > XB_SPIN_CAP) { atomicAdd(&bar[XB_TMO], 1u); break; } }
    }
    nloc = mine > 0u ? mine : 1u; nx = cnt > 0u ? cnt : 1u;
}
__device__ __forceinline__ void xcd_barrier(const XcdBarrier& b) {
    asm volatile("s_waitcnt vmcnt(0)" ::: "memory");
    __syncthreads();
    if (threadIdx.x == 0) {
        unsigned* bar = b.bar;
        __builtin_amdgcn_s_waitcnt(0);
        unsigned nloc = b.st[0], nx = b.st[1];
        if (nloc == 0u) { xcd_barrier_complete(bar, b.x, nloc, nx); b.st[0] = nloc; b.st[1] = nx; }
        const unsigned old = xb_add(&bar[XB_XSUB(b.x)], 1u);
        const unsigned gen = old / nloc;
        if (old + 1u == (gen + 1u) * nloc) {
            __builtin_amdgcn_fence(__ATOMIC_RELEASE, "agent");
            asm volatile("s_waitcnt vmcnt(0)" ::: "memory");
            const unsigned og = xb_add(&bar[XB_TOP], 1u);
            const unsigned tg = og / nx;
            if (og + 1u == (tg + 1u) * nx) xb_add(&bar[XB_TOPGEN], 1u);
            else XB_SPIN(xb_ld(&bar[XB_TOPGEN]) == tg, bar);
            __builtin_amdgcn_fence(__ATOMIC_ACQUIRE, "agent");
            xb_add(&bar[XB_XGEN(b.x)], 1u);
            asm volatile("s_waitcnt vmcnt(0)" ::: "memory");
        } else {
            XB_SPIN(xb_ld(&bar[XB_XGEN(b.x)]) == gen, bar);
            __builtin_amdgcn_fence(__ATOMIC_ACQUIRE, "agent");
            asm volatile("s_waitcnt vmcnt(0)" ::: "memory");
        }
    }
    __syncthreads();
}

__device__ __forceinline__ void xcd_split_arrive(unsigned* w, const XcdBarrier& b) {
    asm volatile("s_waitcnt vmcnt(0)" ::: "memory");
    __syncthreads();
    if (threadIdx.x == 0) {
        const unsigned nloc = b.st[0], nx = b.st[1];
        const unsigned old = xb_add(&w[XB_XSUB(b.x)], 1u);
        if (old + 1u == nloc) {
            __builtin_amdgcn_fence(__ATOMIC_RELEASE, "agent");
            asm volatile("s_waitcnt vmcnt(0)" ::: "memory");
            const unsigned og = xb_add(&w[XB_TOP], 1u);
            if (og + 1u == nx) xb_add(&w[XB_TOPGEN], 1u);
        }
    }
}
__device__ __forceinline__ void xcd_split_wait(unsigned* w, const XcdBarrier& b) {
    if (threadIdx.x == 0) {
        XB_SPIN(xb_ld(&w[XB_TOPGEN]) == 0u, b.bar);
        __builtin_amdgcn_fence(__ATOMIC_ACQUIRE, "agent");
        asm volatile("s_waitcnt vmcnt(0)" ::: "memory");
    }
    __syncthreads();
}

struct Args { const float* in[19]; float* out; unsigned char* ws; int ph_lo, ph_hi; };

__global__ void __launch_bounds__(512, 2) fwd_kernel(Args args) {
    extern __shared__ __attribute__((aligned(16))) unsigned char lds_raw[];
    LAS unsigned char* lds = (LAS unsigned char*)lds_raw;
    const int tid = threadIdx.x, lane = tid & 63, wave = __builtin_amdgcn_readfirstlane(tid >> 6);
    const int G = gridDim.x, bx = blockIdx.x;
    const int vcu = (G % 8 == 0) ? (bx % 8) * (G / 8) + bx / 8 : bx;
    unsigned char* ws = args.ws;
    const float* x_p = args.in[0]; const float* x_s = args.in[1]; const float* g_mix = args.in[2]; const float* w_in = args.in[3]; const float* g_q = args.in[4]; const float* g_k = args.in[5];
    const float* lam_q1 = args.in[6]; const float* lam_k1 = args.in[7]; const float* lam_q2 = args.in[8]; const float* lam_k2 = args.in[9]; const float* g_sub = args.in[10];
    const float* w_attn = args.in[11]; const float* w_four = args.in[12]; const float* w_gate = args.in[13]; const float* b_gate = args.in[14]; const float* w_out = args.in[15];
    const float* g_mlp = args.in[16]; const float* w_up = args.in[17]; const float* w_down = args.in[18];
    float* out = args.out;
    float* SSQ = (float*)(ws + WS_SSQ);
    bf16_t* WUP = (bf16_t*)(ws + WS_WUP); bf16_t* WDN = (bf16_t*)(ws + WS_WDN); bf16_t* XB = (bf16_t*)(ws + WS_XB); bf16_t* QO = (bf16_t*)(ws + WS_QO);
    bf16_t* KB = (bf16_t*)(ws + WS_K); bf16_t* VB = (bf16_t*)(ws + WS_V); bf16_t* FT = (bf16_t*)(ws + WS_FT); bf16_t* W1 = (bf16_t*)(ws + WS_W1); bf16_t* DFT = (bf16_t*)(ws + WS_DFT);
    bf16_t* WMIX = (bf16_t*)(ws + WS_WMIX); bf16_t* WMIX2 = (bf16_t*)(ws + WS_WMIX2); bf16_t* WOUT = (bf16_t*)(ws + WS_WOUT); float* ROPEC = (float*)(ws + WS_ROPE); float* ROPES = ROPEC + SEQ * 32; bf16_t* UB = (bf16_t*)(ws + WS_U);
    bf16_t* G0 = (bf16_t*)out;
    bf16_t* MIXED = KB; bf16_t* PQ = (bf16_t*)out + (size_t)M * DM; bf16_t* X1B = XB;
    float* XN = (float*)(ws + WS_SSQ + 256 * 1024);

    const int lo = args.ph_lo, hi = args.ph_hi;
#define IN(k) (lo <= (k) && (k) < hi)
    unsigned* BARW = (unsigned*)(ws + WS_CTL);
    volatile LAS unsigned* MISC = (volatile LAS unsigned*)(lds + LDS_BYTES - 64);
    if (tid < 16) MISC[tid] = 0u;
    __syncthreads();
    XcdBarrier xbar = xcd_barrier_post(BARW, MISC);
#if MK_N_LAUNCHES == 1
#define SEAM(k) do { if (IN(k) && IN((k) + 1)) xcd_barrier(xbar); } while (0)
#else
#define SEAM(k) do { } while (0)
#endif

    if (IN(0)) for (int rep_ = 0; rep_ < REP_P0; ++rep_) {
        LAS float* scr = (LAS float*)(lds + wave * 16384);
        LAS float* tab = (LAS float*)(lds + 8 * 16384);
        if (tid < 128) { tab[tid] = cospif((float)tid * (1.0f / 64.0f)); tab[128 + tid] = sinpif((float)tid * (1.0f / 64.0f)); }
        __syncthreads();
        const bool wrole = wave >= 4;
        const int gw = vcu * 4 + (wave & 3), NGW = G * 4;
        if (wrole) {
        constexpr int IA = 1024, IB = 512, IC = 1024, ID = 256, NEARLY = IA + IB + IC + ID;
        for (int it = gw; it < NEARLY; it += NGW) {
            int r = it;
            if (r < IA) { const int rb = r >> 4, kb = r & 15, pn = rb >> 3, bj = (rb >> 2) & 1, wc = rb & 3, base = (pn < 4) ? 0 : 1024;
                p0_transpose_item(w_in, 3584, base + 64 * (4 * (pn & 3) + wc) + 32 * bj, 64 * kb, g_mix, 1023, 1.f, W1, 32 * rb, DM, 0, scr, lane); continue; } r -= IA;
            if (r < IB) { const int rb = r >> 4, kb = r & 15; p0_transpose_item(w_in, 3584, 2048 + 32 * rb, 64 * kb, g_mix, 1023, 1.f, W1, 2048 + 32 * rb, DM, 0, scr, lane); continue; } r -= IB;
            if (r < IC) { const int rb = r >> 4, kb = r & 15, pl = rb >> 3, bj = (rb >> 2) & 1, wc = rb & 3;
                p0_transpose_item(w_gate, 2048, bj * 1024 + 128 * pl + 32 * wc, 64 * kb, g_mix, 1023, 1.f, W1, 3072 + 32 * rb, DM, 0, scr, lane); continue; } r -= IC;
            { const int rb = r >> 4, kb = r & 15; p0_transpose_item(w_in, 3584, 3072 + 32 * rb, 64 * kb, g_mix, 1023, 1.f, W1, 5120 + 32 * rb, DM, 0, scr, lane); }
        }
        const int gt = vcu * 256 + (tid & 255), NGT = G * 256;
        for (int it = gt; it < 2048 * 128; it += NGT) { const int r2 = it >> 7, s0 = (it & 127) * 8, parity = r2 >> 10, r = r2 & 1023; const bool special = (parity == 0 && r == 512);
            const int kk = special ? 1024 : 2 * (r & 511) + parity; const bool usecos = (r < 512) || special; float v[8];
#pragma unroll
            for (int e = 0; e < 8; ++e) { const float ang = (float)((kk * (s0 + e)) & 2047) * (1.0f / 1024.0f); v[e] = usecos ? cospif(ang) : sinpif(ang); }
            u32x4 o; o.x = pg8::cvt_pk_bf16(v[0], v[1]); o.y = pg8::cvt_pk_bf16(v[2], v[3]); o.z = pg8::cvt_pk_bf16(v[4], v[5]); o.w = pg8::cvt_pk_bf16(v[6], v[7]);
            *(u32x4*)(DFT + (size_t)r2 * 1024 + s0) = o; }
        for (int it = gt; it < SEQ * 32; it += NGT) { const int s = it >> 5, d = it & 31; double t = (double)s * ROPE_F[d]; t -= __builtin_floor(t); const float a = (float)(2.0 * t);
            ROPEC[it] = cospif(a); ROPES[it] = sinpif(a); }
        for (int it = gt; it < M; it += NGT) SSQ[it] = 0.f;
        } else
        {
            auto xrowp = [&](int m) -> const f32x4* { return (const f32x4*)((m < NB_PROMPT * SEQ) ? x_p + (size_t)m * DM : x_s + (size_t)(m - NB_PROMPT * SEQ) * DM) + lane; };
            f32x4 v[4], w[4], nv[4], nw[4];
            { const f32x4* a = xrowp(gw); const f32x4* b = xrowp(gw + NGW);
#pragma unroll
              for (int j = 0; j < 4; ++j) { nv[j] = __builtin_nontemporal_load(a + 64 * j); nw[j] = __builtin_nontemporal_load(b + 64 * j); } }
            for (int m = gw; m < M; m += 2 * NGW) {
                const int m2 = m + NGW, mn = m + 2 * NGW;
#pragma unroll
                for (int j = 0; j < 4; ++j) { v[j] = nv[j]; w[j] = nw[j]; }
                if (mn < M) { const f32x4* a = xrowp(mn); const f32x4* b = xrowp(mn + NGW);
#pragma unroll
                    for (int j = 0; j < 4; ++j) { nv[j] = __builtin_nontemporal_load(a + 64 * j); nw[j] = __builtin_nontemporal_load(b + 64 * j); } }
                float s0 = 0.f, s1 = 0.f;
#pragma unroll
                for (int j = 0; j < 4; ++j) { s0 += (v[j].x * v[j].x + v[j].y * v[j].y) + (v[j].z * v[j].z + v[j].w * v[j].w); s1 += (w[j].x * w[j].x + w[j].y * w[j].y) + (w[j].z * w[j].z + w[j].w * w[j].w); }
                const float n0 = sqrtf(wave_sum(s0) * (1.0f / DM) + EPS), n1 = sqrtf(wave_sum(s1) * (1.0f / DM) + EPS), r0 = 1.0f / n0, r1 = 1.0f / n1;
                if (lane == 0) { XN[m] = n0; XN[m2] = n1; }
                u32x2* o0 = (u32x2*)(XB + (size_t)m * DM) + lane; u32x2* o1 = (u32x2*)(XB + (size_t)m2 * DM) + lane;
#pragma unroll
                for (int j = 0; j < 4; ++j) { u32x2 a, b; a.x = pg8::cvt_pk_bf16(v[j].x * r0, v[j].y * r0); a.y = pg8::cvt_pk_bf16(v[j].z * r0, v[j].w * r0);
                    b.x = pg8::cvt_pk_bf16(w[j].x * r1, w[j].y * r1); b.y = pg8::cvt_pk_bf16(w[j].z * r1, w[j].w * r1); o0[64 * j] = a; o1[64 * j] = b; }
            }
        }
        __syncthreads();
    }
    SEAM(0);

    if (IN(1)) {
        for (int rep_ = 0; rep_ < REP_P1A; ++rep_)
        { pg8::Gemm g{XB, W1, DM, DM, DM, 0, 0, nullptr, 0, 128, 256, 1}; pg8::StaticOrder S; S.init(M / 256, N1 / 256, 1, G, bx);
          LAS float* cst = (LAS float*)(lds + RING_BYTES);
          for (int i = tid; i < 2240; i += 512) cst[i] = (i < 2048) ? b_gate[i] : (i < 2112) ? g_q[i - 2048] : (i < 2176) ? g_k[i - 2112] : (i < 2208) ? ROPEC[16 * 32 + i - 2176] : ROPES[16 * 32 + i - 2208];
          __syncthreads();
          pg8::EpiG1 E{QO, KB, VB, G0, ROPEC, ROPES, cst};
          pg8::gemm_phase<pg8::EpiG1, true, false>(lds, g, S, E); }
        xcd_split_arrive(BARW + 4096, xbar);
        for (int rep_ = 0; rep_ < REP_P1B; ++rep_)
        { pg8::Gemm g{W1 + (size_t)N1 * DM, XB, DM, DM, DM, 0, (size_t)SEQ * DM, nullptr, 0, 1024, 128, 1 << 30}; pg8::StaticOrder S; S.init(FW / 256, 8, NBATCH, G, bx);
          pg8::EpiFT E{FT};
          pg8::gemm_phase<pg8::EpiFT, true, false>(lds, g, S, E); }
        xcd_split_arrive(BARW + 8192, xbar);
    }

    if (IN(2)) {
        {
            LAS float* scr = (LAS float*)(lds + wave * 16384);
            LAS float* tab = (LAS float*)(lds + 8 * 16384);
            if (tid < 128) { tab[tid] = cospif((float)tid * (1.0f / 64.0f)); tab[128 + tid] = sinpif((float)tid * (1.0f / 64.0f)); }
            __syncthreads();
            const int gw8 = vcu * 8 + wave, NGW8 = G * 8;
            constexpr int IE = 512, IF = 512, IG = 2048, IH = 2048, NLATE = IE + IF + IG + IH;
            for (int it = gw8; it < NLATE; it += NGW8) {
                int r = it;
                if (r < IE) { const int rb = r >> 4, kb = r & 15; p0_transpose_item(w_attn, 1024, 32 * rb, 64 * kb, g_sub, 127, 1.0f - LAMBDA_INIT, WMIX, 32 * rb, 2048, 1024, scr, lane, false, true);
                              p0_transpose_item(w_attn, 1024, 32 * rb, 64 * kb, g_sub, 127, 1.0f - LAMBDA_INIT, WMIX2, 32 * rb, 2048, 1024, scr, lane, false, true); continue; } r -= IE;
                if (r < IF) { const int rb = r >> 4, kb = r & 15; p0_transpose_item(w_out, 1024, 32 * rb, 64 * kb, nullptr, 0, 1.f, WOUT, 32 * rb, DM, 0, scr, lane, false, true); continue; } r -= IF;
                if (r < IG) { const int rb = r >> 4, kb = r & 15; p0_transpose_item(w_up, 4096, 32 * rb, 64 * kb, g_mlp, 1023, 1.f, WUP, 32 * rb, DM, 0, scr, lane, true, true); continue; } r -= IG;
                { const int rb = r >> 6, kb = r & 63; p0_transpose_item(w_down, 1024, 32 * rb, 64 * kb, nullptr, 0, 1.f, WDN, 32 * rb, FF, 0, scr, lane, false, true); }
            }
            for (int it = gw8; it < 1024; it += NGW8) {
                const int pq = it >> 9, gg = (it >> 7) & 3, cb = (it >> 5) & 3, nb = it & 31, r32 = lane & 31, hi = lane >> 5;
                const LAS float* T = tab + pq * 128; const int c = 32 * cb + r32;
                float bv[64];
#pragma unroll
                for (int t = 0; t < 64; ++t) bv[t] = w_four[(size_t)(gg * 128 + 2 * t + hi) * DM + 32 * nb + r32];
                f32x16 acc = f32x16{};
#pragma unroll
                for (int t = 0; t < 64; ++t) acc = __builtin_amdgcn_mfma_f32_32x32x2f32(T[(c * (2 * t + hi)) & 127], bv[t], acc, 0, 0, 0);
                const float sgn = pq ? -(1.0f / 512.0f) : (1.0f / 512.0f);
                bf16_t* orow = WMIX + (size_t)(32 * nb + r32) * 2048 + pq * 512 + gg * 128 + 32 * cb + 4 * hi;
                bf16_t* orow2 = WMIX2 + (orow - WMIX); const unsigned flip = pq ? 0x80008000u : 0u;
#pragma unroll
                for (int q = 0; q < 4; ++q) { u32x2 w; w.x = pg8::cvt_pk_bf16(acc[4 * q] * sgn, acc[4 * q + 1] * sgn); w.y = pg8::cvt_pk_bf16(acc[4 * q + 2] * sgn, acc[4 * q + 3] * sgn); *(u32x2*)(orow + 8 * q) = w;
                    w.x ^= flip; w.y ^= flip; *(u32x2*)(orow2 + 8 * q) = w; }
            }
            __syncthreads();
        }
        xcd_split_wait(BARW + 4096, xbar);
        const float s1 = wave_sum(lam_q1[lane] * lam_k1[lane]), s2 = wave_sum(lam_q2[lane] * lam_k2[lane]);
        const float lam = __expf(s1) - __expf(s2) + LAMBDA_INIT;
        for (int i = 0; ; ++i) { const int L = i * G + vcu, NU = NBATCH * NH * (SEQ / 256); if (L >= NU) break;
            const int bh = L >> 3, qb = L & 7, Ln = L + G, nbh = Ln >> 3;
            att::attn_unit(bh >> 3, bh & 7, qb, i == 0, Ln < NU, nbh >> 3, nbh & 7, QO, KB, VB, lam, (char*)lds_raw); }
        __syncthreads();
        xcd_split_wait(BARW + 8192, xbar);
        for (int rep_ = 0; rep_ < REP_DFT; ++rep_)
        { pg8::Gemm g{DFT, FT, 1024, M, 1024, (size_t)1024 * 1024, 1024, nullptr, 0, 128, 256, NBATCH}; pg8::StaticOrder S; S.init(1024 / 256, FW / 256, 2 * NBATCH, G, (bx + G / 2) % G);
          pg8::EpiDft E{PQ};
          pg8::gemm_phase<pg8::EpiDft, true, false>(lds, g, S, E); }
    }
    SEAM(2);

    if (IN(3)) for (int rep_ = 0; rep_ < REP_P3; ++rep_) {
        pg8::Gemm g{PQ, WMIX, DM, 2048, 2048, 0, 0, QO, 16, 128, 256, 1, WMIX2}; pg8::StaticOrder S; S.init(M / 256, DM / 256, 1, G, bx);
        pg8::EpiMix E{G0, MIXED};
        pg8::gemm_phase<pg8::EpiMix, true, true>(lds, g, S, E);
    }
    SEAM(3);

    if (IN(4)) {
        pg8::Gemm g{MIXED, WOUT, 256, DM, DM, 0, 0, nullptr, 0, 128, 256, 1}; pg8::StaticOrder S; S.init(M / 256, DM / 256, 1, G, bx);
        pg8::EpiOut E{XN, X1B, SSQ};
        pg8::gemm_phase<pg8::EpiOut, true, false>(lds, g, S, E);
    }
    SEAM(4);

    if (IN(5)) for (int rep_ = 0; rep_ < REP_P5; ++rep_) {
        pg8::Gemm g{X1B, WUP, DM, DM, DM, 0, 0, nullptr, 0, 128, 256, 1, nullptr, 1}; pg8::StaticOrder S; S.init(M / 256, FF / 256, 1, G, bx);
        pg8::EpiUp E{SSQ, UB};
        pg8::gemm_phase<pg8::EpiUp, true, false>(lds, g, S, E);
    }
    SEAM(5);

    if (IN(6)) {
        pg8::Gemm g{UB, WDN, 256, FF, FF, 0, 0, nullptr, 0, 128, 256, 1}; pg8::StaticOrder S; S.init(M / 256, DM / 256, 1, G, bx);
        pg8::EpiDown E{out, X1B};
        pg8::gemm_phase<pg8::EpiDown, true, false>(lds, g, S, E);
    }
#undef IN
#undef SEAM
}

extern "C" void kernel_launch(void* const* d_in, const int* in_sizes, int n_in, void* d_out, int out_size, void* d_ws, size_t ws_size, hipStream_t stream) {
    static int grid = 0;
    if (grid == 0) {
        if (n_in != 19 || out_size != M * DM || ws_size < WS_END) { fprintf(stderr, "kernel_launch: unexpected shapes (n_in %d, out %d, ws %zu)\n", n_in, out_size, ws_size); grid = -1; return; }
        int dev = 0, cus = 0, per_cu = 0;
        if (hipGetDevice(&dev) != hipSuccess || hipDeviceGetAttribute(&cus, hipDeviceAttributeMultiprocessorCount, dev) != hipSuccess) { grid = -1; return; }
        if (hipFuncSetAttribute((const void*)fwd_kernel, hipFuncAttributeMaxDynamicSharedMemorySize, LDS_BYTES) != hipSuccess) { fprintf(stderr, "kernel_launch: hipFuncSetAttribute failed\n"); grid = -1; return; }
        if (hipOccupancyMaxActiveBlocksPerMultiprocessor(&per_cu, (const void*)fwd_kernel, 512, LDS_BYTES) != hipSuccess || per_cu < 1) { fprintf(stderr, "kernel_launch: occupancy query says %d\n", per_cu); per_cu = 1; }
        (void)hipGetLastError();
        grid = cus;
        if (grid % 8 != 0) grid -= grid % 8;
    }
    if (grid < 0) return;
    if (hipMemsetAsync((char*)d_ws + WS_CTL, 0, 65536, stream) != hipSuccess) { fprintf(stderr, "kernel_launch: memset of the barrier words failed\n"); return; }
    Args a{};
    for (int i = 0; i < 19; ++i) a.in[i] = (const float*)d_in[i];
    a.out = (float*)d_out; a.ws = (unsigned char*)d_ws;
#if MK_N_LAUNCHES == 1
    a.ph_lo = 0; a.ph_hi = 7;
    void* kargs[] = {&a};
    hipError_t e = hipLaunchCooperativeKernel((const void*)fwd_kernel, dim3(grid), dim3(512), kargs, LDS_BYTES, stream);
    if (e != hipSuccess) fprintf(stderr, "cooperative launch failed: %s (grid %d)\n", hipGetErrorString(e), grid);
#else
    for (int p = 0; p < 7; ++p) { a.ph_lo = p; a.ph_hi = p + 1; hipLaunchKernelGGL(fwd_kernel, dim3(grid), dim3(512), LDS_BYTES, stream, a); }
#endif
}
```
